# Optimizing an MI355X kernel written in HIP

```python
import jax, jax.numpy as jnp
from jax import lax
import numpy as np

D_MODEL = 1024
BATCH = 8
SEQ = 2048
DEPTH = 4
DEC_BATCH = 128
DEC_SEQ = 8
PAST_LEN = 16384
PAGE_SIZE = 128

D_CONV = D_MODEL // 2
CONV_W = 3
D_GMLP = D_MODEL // 2
G_HEADS = 8
G_HEAD_DIM = D_GMLP // G_HEADS
CHUNK = 128
D_POOL = D_MODEL // 2
POOL_WINDOWS = (2, 4, 8, 16)
POOL_GROUPS = len(POOL_WINDOWS)
POOL_GDIM = D_POOL // POOL_GROUPS
POOL_OUT_GDIM = D_MODEL // POOL_GROUPS
MAX_WIN = max(POOL_WINDOWS)
D_FF = 2816
N_SUB = 3
EPS = 1e-6
IN_SIZES = (D_CONV, D_CONV, D_CONV, D_GMLP, D_GMLP, D_POOL, D_MODEL, D_MODEL, D_MODEL)
IN_COLS = sum(IN_SIZES)
IN_SPLITS = tuple(int(s) for s in np.cumsum(IN_SIZES)[:-1])

kernel_name = 'hybrid_conv_gmlp_pool_decoder_step'


def _rmsnorm(x, g):
    xf = x.astype(jnp.float32)
    y = xf * lax.rsqrt(jnp.mean(xf * xf, axis=-1, keepdims=True) + EPS)
    return (y * g.astype(jnp.float32)).astype(x.dtype)


def _layernorm(x, g):
    xf = x.astype(jnp.float32)
    mu = jnp.mean(xf, axis=-1, keepdims=True)
    var = jnp.mean(jnp.square(xf - mu), axis=-1, keepdims=True)
    return ((xf - mu) * lax.rsqrt(var + EPS) * g.astype(jnp.float32)).astype(x.dtype)


def _modulate(h, shift, scale):
    return h * (1 + scale[:, None, :]) + shift[:, None, :]


def _swiglu(h, w_gu, w_dn):
    a, b = jnp.split(h @ w_gu, 2, axis=-1)
    return (jax.nn.silu(a) * b) @ w_dn


def _short_conv(ext, conv_w, L):
    return sum(ext[:, k:k + L] * conv_w[k] for k in range(CONV_W))


def _spatial_gate(v, w_s, b_s):
    bsz, L, _ = v.shape
    w = w_s * jnp.tril(jnp.ones((CHUNK, CHUNK), w_s.dtype))
    bias = b_s.T
    if L < CHUNK:
        vh = v.reshape(bsz, L, G_HEADS, G_HEAD_DIM)
        out = jnp.einsum('hts,bshd->bthd', w[:, :L, :L], vh) + bias[None, :L, :, None]
        return out.reshape(bsz, L, D_GMLP)
    n = -(-L // CHUNK)
    vp = jnp.pad(v, ((0, 0), (0, n * CHUNK - L), (0, 0))).reshape(bsz, n, CHUNK, G_HEADS, G_HEAD_DIM)
    out = jnp.einsum('hts,bnshd->bnthd', w, vp) + bias[None, None, :, :, None]
    return out.reshape(bsz, n * CHUNK, D_GMLP)[:, :L]


def _multi_pool(ext, L, pos0):
    hist = ext.shape[1] - L
    ef = ext.astype(jnp.float32)
    cs = jnp.concatenate([jnp.zeros_like(ef[:, :1]), jnp.cumsum(ef, axis=1)], axis=1)
    pos = pos0 + jnp.arange(L, dtype=jnp.int32)
    outs = []
    for gi, w in enumerate(POOL_WINDOWS):
        cg = cs[:, :, gi * POOL_GDIM:(gi + 1) * POOL_GDIM]
        s = cg[:, hist + 1:hist + 1 + L] - cg[:, hist + 1 - w:hist + 1 - w + L]
        cnt = jnp.minimum(pos + 1, w).astype(jnp.float32)
        outs.append(s / cnt[None, :, None])
    return jnp.concatenate(outs, axis=-1).astype(ext.dtype)


def _mixer(h, hist_conv, hist_pool, pos0, w_in, conv_w, w_out_a, ln_g, w_s, b_s, w_out_b,
           pool_w, pool_scale, w_o):
    bsz, L, _ = h.shape
    xa, bg, cg, u, v, p, ga, gb, gc = jnp.split(h @ w_in, IN_SPLITS, axis=-1)
    ext_c = jnp.concatenate([hist_conv, cg * xa], axis=1)
    y_a = (bg * _short_conv(ext_c, conv_w, L)) @ w_out_a
    new_conv = ext_c[:, -(CONV_W - 1):]
    u = jax.nn.gelu(u, approximate=False)
    v = _layernorm(jax.nn.gelu(v, approximate=False), ln_g)
    y_b = (u * _spatial_gate(v, w_s, b_s)) @ w_out_b
    v_open = v[:, (L // CHUNK) * CHUNK:]
    ext_p = jnp.concatenate([hist_pool, p], axis=1)
    pooled = (_multi_pool(ext_p, L, pos0) - p).reshape(bsz, L, POOL_GROUPS, POOL_GDIM)
    y_c = jnp.einsum('blgc,gcd->blgd', pooled, pool_w).reshape(bsz, L, D_MODEL) * pool_scale
    new_pool = ext_p[:, -(MAX_WIN - 1):]
    merged = jax.nn.sigmoid(ga) * y_a + jax.nn.sigmoid(gb) * y_b + jax.nn.sigmoid(gc) * y_c
    return merged @ w_o, new_conv, new_pool, v_open


def _layer(x, c, hist_conv, hist_pool, pos0, norm_g, w_ada, b_ada, w1_gu, w1_dn, w2_gu, w2_dn,
           w_in, conv_w, w_out_a, ln_g, w_s, b_s, w_out_b, pool_w, pool_scale, w_o):
    bsz = x.shape[0]
    mod = (jax.nn.silu(c) @ w_ada + b_ada).reshape(bsz, N_SUB, 3, D_MODEL)
    h = _modulate(_rmsnorm(x, norm_g[0]), mod[:, 0, 0], mod[:, 0, 1])
    x = x + 0.5 * mod[:, 0, 2][:, None, :] * _swiglu(h, w1_gu, w1_dn)
    h = _modulate(_rmsnorm(x, norm_g[1]), mod[:, 1, 0], mod[:, 1, 1])
    m, new_conv, new_pool, v_open = _mixer(h, hist_conv, hist_pool, pos0, w_in, conv_w, w_out_a,
                                           ln_g, w_s, b_s, w_out_b, pool_w, pool_scale, w_o)
    x = x + mod[:, 1, 2][:, None, :] * m
    h = _modulate(_rmsnorm(x, norm_g[2]), mod[:, 2, 0], mod[:, 2, 1])
    x = x + 0.5 * mod[:, 2, 2][:, None, :] * _swiglu(h, w2_gu, w2_dn)
    return x, new_conv, new_pool, v_open


def setup_inputs(seed: int = 0) -> dict:
    key = jax.random.key(seed)
    ks = jax.random.split(key, 32)
    f32 = jnp.float32

    def nrm(k, shape, scale):
        return jax.random.normal(k, shape, f32) * scale

    return {
        'x_prompt': nrm(ks[0], (BATCH, SEQ, D_MODEL), 1.0),
        'x_sample': nrm(ks[1], (DEC_BATCH, DEC_SEQ, D_MODEL), 1.0),
        'state_conv': nrm(ks[2], (DEPTH, DEC_BATCH, CONV_W - 1, D_CONV), 1.0),
        'state_pool': nrm(ks[3], (DEPTH, DEC_BATCH, MAX_WIN - 1, D_POOL), 1.0),
        'c_prompt': nrm(ks[4], (BATCH, D_MODEL), 1.0),
        'c_sample': nrm(ks[5], (DEC_BATCH, D_MODEL), 1.0),
        'norm_g': 1.0 + nrm(ks[6], (DEPTH, N_SUB, D_MODEL), 0.05),
        'w_ada': nrm(ks[7], (DEPTH, D_MODEL, N_SUB * 3 * D_MODEL), 0.5 * D_MODEL ** -0.5),
        'b_ada': nrm(ks[8], (DEPTH, N_SUB * 3 * D_MODEL), 0.02),
        'w1_gu': nrm(ks[9], (DEPTH, D_MODEL, 2 * D_FF), D_MODEL ** -0.5),
        'w1_dn': nrm(ks[10], (DEPTH, D_FF, D_MODEL), D_FF ** -0.5),
        'w2_gu': nrm(ks[11], (DEPTH, D_MODEL, 2 * D_FF), D_MODEL ** -0.5),
        'w2_dn': nrm(ks[12], (DEPTH, D_FF, D_MODEL), D_FF ** -0.5),
        'w_in': nrm(ks[13], (DEPTH, D_MODEL, IN_COLS), D_MODEL ** -0.5),
        'conv_w': nrm(ks[14], (DEPTH, CONV_W, D_CONV), CONV_W ** -0.5),
        'w_out_a': nrm(ks[15], (DEPTH, D_CONV, D_MODEL), D_CONV ** -0.5),
        'ln_g': 1.0 + nrm(ks[16], (DEPTH, D_GMLP), 0.05),
        'w_s': nrm(ks[17], (DEPTH, G_HEADS, CHUNK, CHUNK), CHUNK ** -0.5),
        'b_s': 1.0 + nrm(ks[18], (DEPTH, G_HEADS, CHUNK), 0.1),
        'w_out_b': nrm(ks[19], (DEPTH, D_GMLP, D_MODEL), D_GMLP ** -0.5),
        'pool_w': nrm(ks[20], (DEPTH, POOL_GROUPS, POOL_GDIM, POOL_OUT_GDIM), POOL_GDIM ** -0.5),
        'pool_scale': 1.0 + nrm(ks[21], (DEPTH, D_MODEL), 0.1),
        'w_o': nrm(ks[22], (DEPTH, D_MODEL, D_MODEL), D_MODEL ** -0.5),
        'final_norm_g': 1.0 + nrm(ks[23], (D_MODEL,), 0.05),
    }


def reference(x_prompt, x_sample, state_conv, state_pool, c_prompt, c_sample, norm_g, w_ada, b_ada,
              w1_gu, w1_dn, w2_gu, w2_dn, w_in, conv_w, w_out_a, ln_g, w_s, b_s, w_out_b,
              pool_w, pool_scale, w_o, final_norm_g):
    xp, xs = x_prompt, x_sample
    bp = xp.shape[0]
    zero_conv = jnp.zeros((bp, CONV_W - 1, D_CONV), xp.dtype)
    zero_pool = jnp.zeros((bp, MAX_WIN - 1, D_POOL), xp.dtype)
    conv_p, conv_s, pool_p, pool_s, v_s = [], [], [], [], []
    for l in range(DEPTH):
        prm = (norm_g[l], w_ada[l], b_ada[l], w1_gu[l], w1_dn[l], w2_gu[l], w2_dn[l], w_in[l],
               conv_w[l], w_out_a[l], ln_g[l], w_s[l], b_s[l], w_out_b[l], pool_w[l],
               pool_scale[l], w_o[l])
        xp, ncp, npp, _ = _layer(xp, c_prompt, zero_conv, zero_pool, 0, *prm)
        xs, ncs, nps, vs = _layer(xs, c_sample, state_conv[l], state_pool[l], PAST_LEN, *prm)
        conv_p.append(ncp)
        pool_p.append(npp)
        conv_s.append(ncs)
        pool_s.append(nps)
        v_s.append(vs)
    y_prompt = _rmsnorm(xp, final_norm_g)
    y_sample = _rmsnorm(xs, final_norm_g)
    new_conv_prompt = jnp.stack(conv_p)
    new_conv_sample = jnp.stack(conv_s)
    new_pool_prompt = jnp.stack(pool_p)
    new_pool_sample = jnp.stack(pool_s)
    new_gmlp_v_sample = jnp.stack(v_s)
    return (y_prompt, y_sample, new_conv_prompt, new_conv_sample, new_pool_prompt, new_pool_sample, new_gmlp_v_sample)
```

```cpp
#include <hip/hip_runtime.h>
#include <hip/hip_cooperative_groups.h>
#include <cstdio>
#include <cstdint>
namespace cg = cooperative_groups;

#define PROBE_PRE 0x0
#define PROBE_MASK 0x00
#ifndef ONE_LAUNCH
#define ONE_LAUNCH 1
#endif

#define GAS __attribute__((address_space(1)))
#define LAS __attribute__((address_space(3)))
typedef unsigned short bf16_t;
typedef short bf16x8 __attribute__((ext_vector_type(8)));
typedef float f32x4 __attribute__((ext_vector_type(4)));
typedef float f32x2 __attribute__((ext_vector_type(2)));
typedef unsigned u32x4 __attribute__((ext_vector_type(4)));
typedef unsigned u32x2 __attribute__((ext_vector_type(2)));

constexpr int D = 1024, TP = 16384, TS = 1024, T = TP + TS, NBATCH = 136, DEPTH = 4, DFF = 2816, NIN = 6144, NADA = 9216;
constexpr int NM = T / 256;
constexpr float EPS = 1e-6f;
constexpr size_t O_YP = 0, O_YS = 16777216, O_CP = 17825792, O_CS = 17858560, O_PP = 18382848, O_PS = 18628608, O_V = 22560768, O_END = 24657920;

constexpr size_t MiB = 1u << 20;
constexpr size_t WS_CTL = 0, CTL_BYTES = 1 * MiB;
constexpr size_t LW_GU1 = 0, LW_DN1 = LW_GU1 + (size_t)5632 * 1024 * 2, LW_GU2 = LW_DN1 + (size_t)1024 * 2816 * 2, LW_DN2 = LW_GU2 + (size_t)5632 * 1024 * 2,
                 LW_IN = LW_DN2 + (size_t)1024 * 2816 * 2, LW_OA = LW_IN + (size_t)6144 * 1024 * 2, LW_OB = LW_OA + (size_t)1024 * 512 * 2, LW_PL = LW_OB + (size_t)1024 * 512 * 2,
                 LW_WO = LW_PL + (size_t)1024 * 128 * 2, LW_TRIL = LW_WO + (size_t)1024 * 1024 * 2, LW_SAMP = LW_TRIL + (size_t)8 * 128 * 128 * 2, LW_SIZE = LW_SAMP + (size_t)8 * 128 * 128 * 2;
static_assert(LW_SIZE == 52166656, "layer weight block");
constexpr size_t WS_W = 1 * MiB;
constexpr size_t WS_ADAW = 200 * MiB;
constexpr size_t WS_SB = WS_ADAW;
constexpr size_t WS_YC = WS_ADAW + 40 * MiB;
constexpr size_t WS_CA = 272 * MiB;
constexpr size_t WS_X = 273 * MiB;
constexpr size_t WS_YAB = WS_X;
constexpr size_t WS_H = 341 * MiB;
constexpr size_t WS_MOD = 375 * MiB;
constexpr size_t WS_R = 395 * MiB;
constexpr size_t WS_PA = WS_R, WS_PG = WS_R + 102 * MiB, WS_G = WS_R, WS_MG = WS_R, WS_SH = WS_R + 150 * MiB;
constexpr size_t WS_SSQ = 616 * MiB;
constexpr size_t SSQ_BYTES = (size_t)13 * T * 4;
constexpr size_t WS_HISTP = 599 * MiB;
constexpr size_t WS_HISTC = 607 * MiB;
constexpr size_t WS_GS = 608 * MiB;
constexpr size_t WS_MGS = 614 * MiB;
constexpr size_t WS_END = 618 * MiB;
constexpr int SB_LD = 69632, SB_LAYER = 17408;
static_assert(WS_W + 4 * LW_SIZE <= WS_ADAW && WS_SB + (size_t)136 * SB_LD * 4 <= WS_YC && WS_YC + (size_t)T * 512 * 2 <= WS_CA && WS_X + (size_t)T * 1024 * 4 <= WS_H && WS_H + (size_t)T * 1024 * 2 <= WS_MOD &&
              WS_MOD + (size_t)136 * 36864 * 4 <= WS_R && WS_PG + (size_t)T * 3072 * 2 <= WS_HISTP && WS_GS + (size_t)TS * DFF * 2 <= WS_MGS && WS_MGS + (size_t)TS * D * 2 <= WS_SSQ && WS_SSQ + SSQ_BYTES <= WS_END, "ws map");

constexpr int LDS_BYTES = 147456, MISC_OFF = LDS_BYTES - 256;
constexpr int VT_PITCH = 136;

#define LDS_WAIT() asm volatile("s_waitcnt lgkmcnt(0)" ::: "memory")
#define VM_WAIT() asm volatile("s_waitcnt vmcnt(0)" ::: "memory")

__device__ __forceinline__ unsigned cvt_pk_bf16(float lo, float hi) { unsigned r; asm volatile("v_cvt_pk_bf16_f32 %0, %1, %2" : "=v"(r) : "v"(lo), "v"(hi)); return r; }
__device__ __forceinline__ float bf_lo(unsigned u) { return __uint_as_float(u << 16); }
__device__ __forceinline__ float bf_hi(unsigned u) { return __uint_as_float(u & 0xffff0000u); }
__device__ __forceinline__ void unpack8(const u32x4 r, float (&v)[8]) { v[0] = bf_lo(r.x); v[1] = bf_hi(r.x); v[2] = bf_lo(r.y); v[3] = bf_hi(r.y); v[4] = bf_lo(r.z); v[5] = bf_hi(r.z); v[6] = bf_lo(r.w); v[7] = bf_hi(r.w); }
__device__ __forceinline__ u32x4 pack8(const float (&v)[8]) { u32x4 r; r.x = cvt_pk_bf16(v[0], v[1]); r.y = cvt_pk_bf16(v[2], v[3]); r.z = cvt_pk_bf16(v[4], v[5]); r.w = cvt_pk_bf16(v[6], v[7]); return r; }
__device__ __forceinline__ float fast_sigmoid(float x) { return __builtin_amdgcn_rcpf(1.0f + __builtin_amdgcn_exp2f(-1.44269504089f * x)); }
__device__ __forceinline__ float fast_silu(float x) { return x * fast_sigmoid(x); }
template <class Tp> __device__ __forceinline__ Tp* sel_ptr(bool c, Tp* a, Tp* b) { const unsigned long long ua = (unsigned long long)a, ub = (unsigned long long)b; return (Tp*)(ub ^ ((ua ^ ub) & (0ull - (unsigned long long)c))); }
__device__ __forceinline__ int row_batch(int r) { return r < TP ? (r >> 11) : 8 + ((r - TP) >> 3); }
__device__ __forceinline__ float wave_sum(float v, int lane) {
#pragma unroll
    for (int o = 1; o < 64; o <<= 1) v += __int_as_float(__builtin_amdgcn_ds_bpermute((lane ^ o) << 2, __float_as_int(v)));
    return v;
}
__device__ __forceinline__ f32x2 gelu_pk(f32x2 v) {
    const f32x2 av = __builtin_elementwise_abs(v), d = av * 0.2316418882f + 1.0f;
    f32x2 t; t.x = __builtin_amdgcn_rcpf(d.x); t.y = __builtin_amdgcn_rcpf(d.y);
    f32x2 q = t * 0.5307027145f + (-0.7265760135f); q = q * t + 0.7107068705f; q = q * t + (-0.142248368f); q = q * t + 0.127414796f; q = q * t;
    const f32x2 s = (v * v) * (-0.72134752044f);
    f32x2 e; e.x = __builtin_amdgcn_exp2f(s.x); e.y = __builtin_amdgcn_exp2f(s.y);
    const f32x2 m = v * (q * e), r = v - m;
    f32x2 o; o.x = v.x < 0.f ? m.x : r.x; o.y = v.y < 0.f ? m.y : r.y; return o;
}

namespace pg8 {
constexpr int BM = 256, BK = 64, HALF = 128, HTB = HALF * BK * 2, STAGE_BYTES = 8 * HTB, NXCD = 8, WGM = 8;
__host__ __device__ __forceinline__ int lds_byte(int r, int c) { const int st = (r >> 4) * 2 + (c >> 5), rr = r & 15, cc = c & 31, ob = rr * 64 + cc * 2; return st * 1024 + (ob ^ (((ob >> 9) & 1) << 5)); }
__host__ __device__ __forceinline__ void stage_rc(int b, int& R, int& C) { const int st = b / 1024, sb = b % 1024, swz = sb ^ (((sb >> 9) & 1) << 5); R = (st >> 1) * 16 + swz / 64; C = (st & 1) * 32 + (swz % 64) / 2; }
__host__ __device__ __forceinline__ int perm32(int rho) { const int n = rho >> 4, i = rho & 15; return 8 * (i >> 2) + 4 * n + (i & 3); }

struct Unit { int pm, pn, job; };
struct Gemm { const bf16_t* A; const bf16_t* Bt; int lda, ldb, K, a_pn_off; size_t a_pm_stride, b_pm_stride; };

struct StaticOrder {
    int pm0, nM, nN, nwg, Gp, v, skc, skr, i0, rend;
    __device__ void init(int pm0_, int nM_, int nN_, int G, int c, int cu_off, int cu_cnt, int skc_, int skr_, int i0_ = 0, int rend_ = 1 << 20) { pm0 = pm0_; nM = nM_; nN = nN_; nwg = nM * nN; Gp = cu_cnt; skc = skc_; skr = skr_; i0 = i0_; rend = rend_;
        int vv = c - cu_off; if (vv < 0) vv += G; v = vv < cu_cnt ? vv : -1; }
    __device__ void init(int nM_, int nN_, int G, int c) { init(0, nM_, nN_, G, c, 0, G, 0, 0); }
    __device__ bool next(int i, Unit& u) const {
        if (v < 0) return false;
        const int r0 = v < skc ? skr : 0, r = (r0 > i0 ? r0 : i0) + i;
        if (r >= rend) return false;
        const long L = r < skr ? (long)r * (Gp - skc) + (v - skc) : (long)skr * (Gp - skc) + (long)(r - skr) * Gp + v;
        if (L >= nwg) return false;
        int wgid = (int)L; { const int q = nwg / NXCD, r = nwg % NXCD, xcd = wgid % NXCD, off = wgid / NXCD; wgid = (xcd < r ? xcd * (q + 1) : r * (q + 1) + (xcd - r) * q) + off; }
        const int nig = WGM * nN, gid = wgid / nig, fm = gid * WGM, gsz = (nM - fm) < WGM ? (nM - fm) : WGM;
        u.pm = pm0 + fm + ((wgid % nig) % gsz); u.pn = (wgid % nig) / gsz; return true;
    }
    __device__ __forceinline__ void a_ready(const Unit&) const {}
    __device__ __forceinline__ void done(const Unit&) const {}
};

template <class Epi, class Sched>
__device__ __forceinline__ void gemm_phase(LAS unsigned char* lds, const Gemm g, const Sched& S, const Epi& E, const int tid) {
    const int wid = __builtin_amdgcn_readfirstlane(tid >> 6), lane = tid & 63, wr = wid >> 2, wc = wid & 3, fr = lane & 15, fq = lane >> 4;
    const int nt = g.K / BK;
    unsigned voffA[2], voffB[2];
#pragma unroll
    for (int i = 0; i < 2; ++i) { int R, C; stage_rc(tid * 16 + i * 8192, R, C); const int Rb = Epi::PERM ? ((R & ~31) + perm32(R & 31)) : R;
        voffA[i] = (unsigned)(R * g.lda + C) * 2u; voffB[i] = (unsigned)(Rb * g.ldb + C) * 2u; }
    const size_t kstep = (size_t)(BK * 2);
    const size_t hstepA = (size_t)HALF * g.lda * 2, hstepB = (size_t)HALF * g.ldb * 2;
    const size_t tstepB = 2 * hstepB;
    const size_t pnoffA = (size_t)g.a_pn_off * 2;
    const unsigned ldsw = (unsigned)wid * 1024u;
    const int aoff = lds_byte(wr * 64 + fr, fq * 8), boff = lds_byte(wc * 32 + fr, fq * 8);
#define PG8_SA(b, h) (((b) * 2 + (h)) * HTB)
#define PG8_SB(b, h) ((4 + (b) * 2 + (h)) * HTB)
#define PG8_STAGE(bufoff, gbase, voff) do { _Pragma("unroll") for (int _i = 0; _i < 2; ++_i) \
        __builtin_amdgcn_global_load_lds((const GAS unsigned*)((const char*)(gbase) + (voff)[_i]), (LAS unsigned*)(lds + (bufoff) + ldsw + _i * 8192), 16, 0, 0); } while (0)
#define PG8_LDA(dst, b, h) do { _Pragma("unroll") for (int m = 0; m < 4; ++m) _Pragma("unroll") for (int k = 0; k < 2; ++k) dst[m][k] = *(const LAS bf16x8*)(lds + PG8_SA(b, h) + aoff + m * 2048 + k * 1024); } while (0)
#define PG8_LDB(dst, b, h) do { _Pragma("unroll") for (int n = 0; n < 2; ++n) _Pragma("unroll") for (int k = 0; k < 2; ++k) dst[n][k] = *(const LAS bf16x8*)(lds + PG8_SB(b, h) + boff + n * 2048 + k * 1024); } while (0)
#define PG8_MMA(ai, bj, At, Bt) do { __builtin_amdgcn_s_setprio(1); _Pragma("unroll") for (int m = 0; m < 4; ++m) _Pragma("unroll") for (int n = 0; n < 2; ++n) _Pragma("unroll") for (int k = 0; k < 2; ++k) \
        acc[ai][bj][m][n] = __builtin_amdgcn_mfma_f32_16x16x32_bf16(Bt[n][k], At[m][k], acc[ai][bj][m][n], 0, 0, 0); __builtin_amdgcn_s_setprio(0); } while (0)
#define PG8_WAIT_V(n) asm volatile("s_waitcnt vmcnt(" #n ")" ::: "memory")
#define PG8_WAIT_L(n) asm volatile("s_waitcnt lgkmcnt(" #n ")" ::: "memory")
#define PG8_BAR __builtin_amdgcn_s_barrier()
#define PG8_SCHED __builtin_amdgcn_sched_barrier(0)
    Unit cur, nxt; int ui = 0;
    if (!S.next(0, cur)) return;
    f32x4 acc[2][2][4][2];
#pragma unroll
    for (int a = 0; a < 2; ++a)
#pragma unroll
        for (int b = 0; b < 2; ++b)
#pragma unroll
            for (int m = 0; m < 4; ++m)
#pragma unroll
                for (int n = 0; n < 2; ++n) acc[a][b][m][n] = (f32x4){0.f, 0.f, 0.f, 0.f};
    bf16x8 At[4][2], B0[2][2], B1[2][2];
    typename Epi::Pre pre = {};
    const char* cA = (const char*)g.A + (size_t)cur.pm * g.a_pm_stride + (size_t)cur.pn * pnoffA; const char* cB = (const char*)g.Bt + (size_t)cur.pn * tstepB + (size_t)cur.pm * g.b_pm_stride;
    S.a_ready(cur);
    PG8_STAGE(PG8_SB(0, 0), cB, voffB); PG8_STAGE(PG8_SB(0, 1), cB + hstepB, voffB); PG8_STAGE(PG8_SA(0, 0), cA, voffA); PG8_STAGE(PG8_SA(0, 1), cA + hstepA, voffA);
    if (wr == 1) PG8_BAR;
    PG8_WAIT_V(2); PG8_BAR;
    PG8_STAGE(PG8_SB(1, 0), cB + kstep, voffB); PG8_STAGE(PG8_SA(1, 0), cA + kstep, voffA); PG8_STAGE(PG8_SB(1, 1), cB + hstepB + kstep, voffB);
    PG8_WAIT_V(6); PG8_BAR;
    for (;;) {
        const bool has_next = S.next(ui + 1, nxt);
        const char* nA = has_next ? (const char*)g.A + (size_t)nxt.pm * g.a_pm_stride + (size_t)nxt.pn * pnoffA : cA; const char* nB = has_next ? (const char*)g.Bt + (size_t)nxt.pn * tstepB + (size_t)nxt.pm * g.b_pm_stride : cB;
        for (int t = 0; t < nt; t += 2) {
            const bool last = (t == nt - 2);
            const char* a1 = cA + (size_t)(t + 1) * kstep;
            const char* a2 = last ? nA : cA + (size_t)(t + 2) * kstep; const char* b2 = last ? nB : cB + (size_t)(t + 2) * kstep;
            const char* a3 = a2 + kstep; const char* b3 = b2 + kstep;
            if (last && has_next) S.a_ready(nxt);
            if (last) { pre = E.pre(cur, wr, wc, fr, fq); PG8_SCHED; }
            PG8_LDB(B0, 0, 0); PG8_LDB(B1, 0, 1); PG8_SCHED; PG8_LDA(At, 0, 0); PG8_STAGE(PG8_SA(1, 1), a1 + hstepA, voffA);
            PG8_WAIT_V(8); PG8_WAIT_L(0); PG8_BAR; PG8_MMA(0, 0, At, B0); PG8_MMA(0, 1, At, B1); PG8_BAR; PG8_SCHED;
            PG8_LDA(At, 0, 1); PG8_STAGE(PG8_SB(0, 0), b2, voffB); PG8_STAGE(PG8_SB(0, 1), b2 + hstepB, voffB); PG8_STAGE(PG8_SA(0, 0), a2, voffA);
            PG8_WAIT_V(8); PG8_WAIT_L(0); PG8_BAR; PG8_MMA(1, 0, At, B0); PG8_MMA(1, 1, At, B1); PG8_BAR; PG8_SCHED;
            PG8_LDB(B0, 1, 0); PG8_LDB(B1, 1, 1); PG8_SCHED; PG8_LDA(At, 1, 0); PG8_STAGE(PG8_SA(0, 1), a2 + hstepA, voffA);
            PG8_WAIT_V(8); PG8_WAIT_L(0); PG8_BAR; PG8_MMA(0, 0, At, B0); PG8_MMA(0, 1, At, B1); PG8_BAR; PG8_SCHED;
            PG8_LDA(At, 1, 1); PG8_STAGE(PG8_SB(1, 0), b3, voffB); PG8_STAGE(PG8_SB(1, 1), b3 + hstepB, voffB); PG8_STAGE(PG8_SA(1, 0), a3, voffA);
            PG8_WAIT_V(8); PG8_WAIT_L(0); PG8_BAR; PG8_MMA(1, 0, At, B0); PG8_MMA(1, 1, At, B1); PG8_BAR; PG8_SCHED;
        }
        if (wr == 0) PG8_BAR;
        { Unit eu; eu.pm = __builtin_amdgcn_readfirstlane(cur.pm); eu.pn = __builtin_amdgcn_readfirstlane(cur.pn); eu.job = 0; asm volatile("" : "+s"(eu.pm), "+s"(eu.pn));
          int efr = fr; asm volatile("" : "+v"(efr));
          E(acc, eu, wr, wc, efr, fq, pre); }
        S.done(cur);
        if (!has_next) break;
#pragma unroll
        for (int a = 0; a < 2; ++a)
#pragma unroll
            for (int b = 0; b < 2; ++b)
#pragma unroll
                for (int m = 0; m < 4; ++m)
#pragma unroll
                    for (int n = 0; n < 2; ++n) acc[a][b][m][n] = (f32x4){0.f, 0.f, 0.f, 0.f};
        cur = nxt; cA = nA; cB = nB; ++ui;
        if (wr == 1) PG8_BAR;
    }
    PG8_WAIT_V(0);
    PG8_BAR;
#undef PG8_SA
#undef PG8_SB
#undef PG8_STAGE
#undef PG8_LDA
#undef PG8_LDB
#undef PG8_MMA
#undef PG8_WAIT_V
#undef PG8_WAIT_L
#undef PG8_BAR
#undef PG8_SCHED
}
template <class Epi, class Sched>
__device__ __forceinline__ void gemm_phase3(LAS unsigned char* lds, const Gemm (&gj)[3], const Sched& S, const Epi& E, const int tid) {
    const int wid = __builtin_amdgcn_readfirstlane(tid >> 6), lane = tid & 63, wr = wid >> 2, wc = wid & 3, fr = lane & 15, fq = lane >> 4;
    int sR[2], sRb[2], sC[2];
#pragma unroll
    for (int i = 0; i < 2; ++i) { stage_rc(tid * 16 + i * 8192, sR[i], sC[i]); sRb[i] = Epi::PERM ? ((sR[i] & ~31) + perm32(sR[i] & 31)) : sR[i]; }
    const size_t kstep = (size_t)(BK * 2);
    int nt; unsigned voffA[2], voffB[2], nvoffA[2], nvoffB[2]; size_t hstepA, hstepB, nhstepA, nhstepB;
#define PG8_JOBPARAMS(J, VA, VB, HA, HB) do { _Pragma("unroll") for (int _i = 0; _i < 2; ++_i) { VA[_i] = (unsigned)(sR[_i] * gj[J].lda + sC[_i]) * 2u; VB[_i] = (unsigned)(sRb[_i] * gj[J].ldb + sC[_i]) * 2u; } \
        HA = (size_t)HALF * gj[J].lda * 2; HB = (size_t)HALF * gj[J].ldb * 2; } while (0)
#define PG8_ABASE(J, U) ((const char*)gj[J].A + (size_t)(U).pm * gj[J].a_pm_stride + (size_t)(U).pn * ((size_t)gj[J].a_pn_off * 2))
#define PG8_BBASE(J, U) ((const char*)gj[J].Bt + (size_t)(U).pn * ((size_t)BM * gj[J].ldb * 2) + (size_t)(U).pm * gj[J].b_pm_stride)
    const unsigned ldsw = (unsigned)wid * 1024u;
    const int aoff = lds_byte(wr * 64 + fr, fq * 8), boff = lds_byte(wc * 32 + fr, fq * 8);
#define PG8_SA(b, h) (((b) * 2 + (h)) * HTB)
#define PG8_SB(b, h) ((4 + (b) * 2 + (h)) * HTB)
#define PG8_STAGE(bufoff, gbase, voff) do { _Pragma("unroll") for (int _i = 0; _i < 2; ++_i) \
        __builtin_amdgcn_global_load_lds((const GAS unsigned*)((const char*)(gbase) + (voff)[_i]), (LAS unsigned*)(lds + (bufoff) + ldsw + _i * 8192), 16, 0, 0); } while (0)
#define PG8_LDA(dst, b, h) do { _Pragma("unroll") for (int m = 0; m < 4; ++m) _Pragma("unroll") for (int k = 0; k < 2; ++k) dst[m][k] = *(const LAS bf16x8*)(lds + PG8_SA(b, h) + aoff + m * 2048 + k * 1024); } while (0)
#define PG8_LDB(dst, b, h) do { _Pragma("unroll") for (int n = 0; n < 2; ++n) _Pragma("unroll") for (int k = 0; k < 2; ++k) dst[n][k] = *(const LAS bf16x8*)(lds + PG8_SB(b, h) + boff + n * 2048 + k * 1024); } while (0)
#define PG8_MMA(ai, bj, At, Bt) do { __builtin_amdgcn_s_setprio(1); _Pragma("unroll") for (int m = 0; m < 4; ++m) _Pragma("unroll") for (int n = 0; n < 2; ++n) _Pragma("unroll") for (int k = 0; k < 2; ++k) \
        acc[ai][bj][m][n] = __builtin_amdgcn_mfma_f32_16x16x32_bf16(Bt[n][k], At[m][k], acc[ai][bj][m][n], 0, 0, 0); __builtin_amdgcn_s_setprio(0); } while (0)
#define PG8_WAIT_V(n) asm volatile("s_waitcnt vmcnt(" #n ")" ::: "memory")
#define PG8_WAIT_L(n) asm volatile("s_waitcnt lgkmcnt(" #n ")" ::: "memory")
#define PG8_BAR __builtin_amdgcn_s_barrier()
#define PG8_SCHED __builtin_amdgcn_sched_barrier(0)
    Unit cur, nxt; int ui = 0;
    if (!S.next(0, cur)) return;
    cur.job = 0; PG8_JOBPARAMS(0, voffA, voffB, hstepA, hstepB); nt = gj[0].K / BK;
    f32x4 acc[2][2][4][2];
#pragma unroll
    for (int a = 0; a < 2; ++a)
#pragma unroll
        for (int b = 0; b < 2; ++b)
#pragma unroll
            for (int m = 0; m < 4; ++m)
#pragma unroll
                for (int n = 0; n < 2; ++n) acc[a][b][m][n] = (f32x4){0.f, 0.f, 0.f, 0.f};
    bf16x8 At[4][2], B0[2][2], B1[2][2];
    typename Epi::Pre pre = {};
    const char* cA = PG8_ABASE(0, cur); const char* cB = PG8_BBASE(0, cur);
    S.a_ready(cur);
    PG8_STAGE(PG8_SB(0, 0), cB, voffB); PG8_STAGE(PG8_SB(0, 1), cB + hstepB, voffB); PG8_STAGE(PG8_SA(0, 0), cA, voffA); PG8_STAGE(PG8_SA(0, 1), cA + hstepA, voffA);
    if (wr == 1) PG8_BAR;
    PG8_WAIT_V(2); PG8_BAR;
    PG8_STAGE(PG8_SB(1, 0), cB + kstep, voffB); PG8_STAGE(PG8_SA(1, 0), cA + kstep, voffA); PG8_STAGE(PG8_SB(1, 1), cB + hstepB + kstep, voffB);
    PG8_WAIT_V(6); PG8_BAR;
    for (;;) {
        const int nj = (ui + 1) % 3;
        const bool has_next = S.next((ui + 1) / 3, nxt); nxt.job = nj;
        const char* nA = cA; const char* nB = cB;
#pragma unroll
        for (int _i = 0; _i < 2; ++_i) { nvoffA[_i] = voffA[_i]; nvoffB[_i] = voffB[_i]; } nhstepA = hstepA; nhstepB = hstepB;
        if (has_next) { if (nj == 0) { PG8_JOBPARAMS(0, nvoffA, nvoffB, nhstepA, nhstepB); nA = PG8_ABASE(0, nxt); nB = PG8_BBASE(0, nxt); }
                        else if (nj == 1) { PG8_JOBPARAMS(1, nvoffA, nvoffB, nhstepA, nhstepB); nA = PG8_ABASE(1, nxt); nB = PG8_BBASE(1, nxt); }
                        else { PG8_JOBPARAMS(2, nvoffA, nvoffB, nhstepA, nhstepB); nA = PG8_ABASE(2, nxt); nB = PG8_BBASE(2, nxt); } }
        for (int t = 0; t < nt; t += 2) {
            const bool last = (t == nt - 2);
            const char* a1 = cA + (size_t)(t + 1) * kstep;
            const char* a2 = last ? nA : cA + (size_t)(t + 2) * kstep; const char* b2 = last ? nB : cB + (size_t)(t + 2) * kstep;
            const char* a3 = a2 + kstep; const char* b3 = b2 + kstep;
            unsigned vA2[2], vB2[2]; vA2[0] = last ? nvoffA[0] : voffA[0]; vA2[1] = last ? nvoffA[1] : voffA[1]; vB2[0] = last ? nvoffB[0] : voffB[0]; vB2[1] = last ? nvoffB[1] : voffB[1];
            const size_t hA2 = last ? nhstepA : hstepA, hB2 = last ? nhstepB : hstepB;
            if (last && has_next) S.a_ready(nxt);
            if (last) { pre = E.pre(cur, wr, wc, fr, fq); PG8_SCHED; }
            PG8_LDB(B0, 0, 0); PG8_LDB(B1, 0, 1); PG8_SCHED; PG8_LDA(At, 0, 0); PG8_STAGE(PG8_SA(1, 1), a1 + hstepA, voffA);
            PG8_WAIT_V(8); PG8_WAIT_L(0); PG8_BAR; PG8_MMA(0, 0, At, B0); PG8_MMA(0, 1, At, B1); PG8_BAR; PG8_SCHED;
            PG8_LDA(At, 0, 1); PG8_STAGE(PG8_SB(0, 0), b2, vB2); PG8_STAGE(PG8_SB(0, 1), b2 + hB2, vB2); PG8_STAGE(PG8_SA(0, 0), a2, vA2);
            PG8_WAIT_V(8); PG8_WAIT_L(0); PG8_BAR; PG8_MMA(1, 0, At, B0); PG8_MMA(1, 1, At, B1); PG8_BAR; PG8_SCHED;
            PG8_LDB(B0, 1, 0); PG8_LDB(B1, 1, 1); PG8_SCHED; PG8_LDA(At, 1, 0); PG8_STAGE(PG8_SA(0, 1), a2 + hA2, vA2);
            PG8_WAIT_V(8); PG8_WAIT_L(0); PG8_BAR; PG8_MMA(0, 0, At, B0); PG8_MMA(0, 1, At, B1); PG8_BAR; PG8_SCHED;
            PG8_LDA(At, 1, 1); PG8_STAGE(PG8_SB(1, 0), b3, vB2); PG8_STAGE(PG8_SB(1, 1), b3 + hB2, vB2); PG8_STAGE(PG8_SA(1, 0), a3, vA2);
            PG8_WAIT_V(8); PG8_WAIT_L(0); PG8_BAR; PG8_MMA(1, 0, At, B0); PG8_MMA(1, 1, At, B1); PG8_BAR; PG8_SCHED;
        }
        if (wr == 0) PG8_BAR;
        { Unit eu; eu.pm = __builtin_amdgcn_readfirstlane(cur.pm); eu.pn = __builtin_amdgcn_readfirstlane(cur.pn); eu.job = __builtin_amdgcn_readfirstlane(cur.job); asm volatile("" : "+s"(eu.pm), "+s"(eu.pn));
          int efr = fr; asm volatile("" : "+v"(efr));
          E(acc, eu, wr, wc, efr, fq, pre); }
        S.done(cur);
        if (!has_next) break;
        if (nxt.job == 0)
#pragma unroll
        for (int a = 0; a < 2; ++a)
#pragma unroll
            for (int b = 0; b < 2; ++b)
#pragma unroll
                for (int m = 0; m < 4; ++m)
#pragma unroll
                    for (int n = 0; n < 2; ++n) acc[a][b][m][n] = (f32x4){0.f, 0.f, 0.f, 0.f};
        cur = nxt; cA = nA; cB = nB; ++ui;
#pragma unroll
        for (int _i = 0; _i < 2; ++_i) { voffA[_i] = nvoffA[_i]; voffB[_i] = nvoffB[_i]; } hstepA = nhstepA; hstepB = nhstepB; nt = gj[0].K / BK; if (cur.job == 1) nt = gj[1].K / BK; if (cur.job == 2) nt = gj[2].K / BK;
        if (wr == 1) PG8_BAR;
    }
    PG8_WAIT_V(0);
    PG8_BAR;
#undef PG8_JOBPARAMS
#undef PG8_ABASE
#undef PG8_BBASE
#undef PG8_SA
#undef PG8_SB
#undef PG8_STAGE
#undef PG8_LDA
#undef PG8_LDB
#undef PG8_MMA
#undef PG8_WAIT_V
#undef PG8_WAIT_L
#undef PG8_BAR
#undef PG8_SCHED
}
}

typedef unsigned ssq_t;
constexpr float SSQ_SCALE = 4096.0f, SSQ_INV = 1.0f / 4096.0f;
__device__ __forceinline__ float row_rstd(const ssq_t* ssq, int r) { return __builtin_amdgcn_rsqf((float)*(const GAS ssq_t*)(ssq + r) * (SSQ_INV / D) + EPS); }
struct EpiAda {
    static constexpr bool PERM = false;
    float* mod; const float* bias; const float* normg; bf16_t* sh;
    struct Pre {}; __device__ __forceinline__ Pre pre(const pg8::Unit&, int, int, int, int) const { return Pre{}; }
    __device__ __forceinline__ void operator()(const f32x4 (&acc)[2][2][4][2], const pg8::Unit& u, int wr, int wc, int fr, int fq, const Pre&) const {
        const int row0 = wr * 64 + fr, col0 = u.pn * 256 + wc * 32 + 4 * fq;
        const int l = (u.pn * 256) / NADA, rem = u.pn * 256 - l * NADA, sub3 = rem >> 10, which = sub3 % 3, sub = sub3 / 3, d0 = (rem & 1023) + wc * 32 + 4 * fq;
#pragma unroll
        for (int ai = 0; ai < 2; ++ai)
#pragma unroll
            for (int m = 0; m < 4; ++m) { const int r = row0 + ai * 128 + m * 16;
                if (r < NBATCH) {
#pragma unroll
                    for (int bj = 0; bj < 2; ++bj)
#pragma unroll
                        for (int n = 0; n < 2; ++n) { const int o = bj * 128 + n * 16; f32x4 v = acc[ai][bj][m][n] + *(const GAS f32x4*)(bias + col0 + o);
                            if (which == 0) { u32x2 w; w.x = cvt_pk_bf16(v[0], v[1]); w.y = cvt_pk_bf16(v[2], v[3]); *(GAS u32x2*)(sh + ((size_t)(l * 3 + sub) * 256 + r) * D + d0 + o) = w; }
                            else { if (which == 1) v = *(const GAS f32x4*)(normg + (l * 3 + sub) * D + d0 + o) * (v + 1.0f);
                                *(GAS f32x4*)(mod + (size_t)r * 36864 + col0 + o) = v; } } } }
    }
};
struct EpiSB {
    static constexpr bool PERM = false;
    float* sb; int off;
    struct Pre {}; __device__ __forceinline__ Pre pre(const pg8::Unit&, int, int, int, int) const { return Pre{}; }
    __device__ __forceinline__ void operator()(const f32x4 (&acc)[2][2][4][2], const pg8::Unit& u, int wr, int wc, int fr, int fq, const Pre&) const {
        const int row0 = wr * 64 + fr, col0 = u.pm * SB_LAYER + off + u.pn * 256 + wc * 32 + 4 * fq;
#pragma unroll
        for (int ai = 0; ai < 2; ++ai)
#pragma unroll
            for (int m = 0; m < 4; ++m) { const int r = row0 + ai * 128 + m * 16;
                if (r < NBATCH) {
#pragma unroll
                    for (int bj = 0; bj < 2; ++bj)
#pragma unroll
                        for (int n = 0; n < 2; ++n) *(GAS f32x4*)(sb + (size_t)r * SB_LD + col0 + bj * 128 + n * 16) = acc[ai][bj][m][n]; } }
    }
};
struct EpiSwiglu {
    static constexpr bool PERM = true;
    bf16_t* G; bf16_t* GSv; const ssq_t* ssq; const float* sb;
    struct Pre { ssq_t rs[8]; f32x4 sa[2], sbb[2]; };
    __device__ __forceinline__ Pre pre(const pg8::Unit& u, int wr, int wc, int fr, int fq) const {
        Pre p; const int row0 = u.pm * 256 + wr * 64 + fr, scol = u.pn * 256 + wc * 32 + 8 * fq;
#pragma unroll
        for (int i = 0; i < 8; ++i) p.rs[i] = *(const GAS ssq_t*)(ssq + row0 + (i >> 2) * 128 + (i & 3) * 16);
        const float* sp = sb + (size_t)(u.pm < 64 ? (u.pm >> 3) : 0) * SB_LD + scol;
#pragma unroll
        for (int n = 0; n < 2; ++n) { p.sa[n] = *(const GAS f32x4*)(sp + 4 * n); p.sbb[n] = *(const GAS f32x4*)(sp + 128 + 4 * n); }
        return p;
    }
    __device__ __forceinline__ void operator()(const f32x4 (&acc)[2][2][4][2], const pg8::Unit& u, int wr, int wc, int fr, int fq, const Pre& p) const {
        const int row0 = u.pm * 256 + wr * 64 + fr, col0 = u.pn * 128 + wc * 32 + 8 * fq, scol = u.pn * 256 + wc * 32 + 8 * fq;
        const bool uni = u.pm < 64;
        bf16_t* Gb = sel_ptr(uni, G, GSv);
        float rs[8];
#pragma unroll
        for (int i = 0; i < 8; ++i) rs[i] = (float)p.rs[i] * SSQ_INV;
        f32x4 sa[2], sbb[2];
#pragma unroll
        for (int n = 0; n < 2; ++n) { sa[n] = p.sa[n]; sbb[n] = p.sbb[n]; }
#pragma unroll
        for (int i = 0; i < 8; ++i) { const int ai = i >> 2, m = i & 3, r = row0 + ai * 128 + m * 16; const float rr = __builtin_amdgcn_rsqf(rs[i] * (1.f / D) + EPS); float v[8];
            if (!uni) { const float* sp = sb + (size_t)row_batch(r) * SB_LD + scol;
#pragma unroll
                for (int n = 0; n < 2; ++n) { sa[n] = *(const GAS f32x4*)(sp + 4 * n); sbb[n] = *(const GAS f32x4*)(sp + 128 + 4 * n); } }
#pragma unroll
            for (int n = 0; n < 2; ++n)
#pragma unroll
                for (int j = 0; j < 4; ++j) v[n * 4 + j] = fast_silu(acc[ai][0][m][n][j] * rr + sa[n][j]) * (acc[ai][1][m][n][j] * rr + sbb[n][j]);
            *(GAS u32x4*)(Gb + (size_t)r * DFF + col0) = pack8(v); }
    }
};
struct EpiResid {
    static constexpr bool PERM = true;
    const float* gate0; const float* gsc0; const float* gsn0; bf16_t* H; ssq_t* ssq; float s; int fin;
    struct Pre {}; __device__ __forceinline__ Pre pre(const pg8::Unit&, int, int, int, int) const { return Pre{}; }
    __device__ __forceinline__ void operator()(const f32x4 (&acc)[2][2][4][2], const pg8::Unit& u, int wr, int wc, int fr, int fq, const Pre&) const {
        const int row0 = u.pm * 256 + wr * 64 + fr, col0 = u.pn * 256 + wc * 32 + 8 * fq, ln = fr + 16 * fq;
        const bool uni = u.pm < 64;
        f32x4 g[2][2], hs[2][2], rc[2][2];
#define ER_LOAD(bo) do { _Pragma("unroll") for (int bj = 0; bj < 2; ++bj) _Pragma("unroll") for (int n = 0; n < 2; ++n) { const size_t o = (bo) + bj * 128 + n * 4; g[bj][n] = *(const GAS f32x4*)(gate0 + o) * s; \
            const f32x4 c = *(const GAS f32x4*)(gsc0 + o); rc[bj][n] = (f32x4){__builtin_amdgcn_rcpf(c[0]), __builtin_amdgcn_rcpf(c[1]), __builtin_amdgcn_rcpf(c[2]), __builtin_amdgcn_rcpf(c[3])}; \
            hs[bj][n] = fin ? (f32x4){1.f, 1.f, 1.f, 1.f} : *(const GAS f32x4*)(gsn0 + o); } } while (0)
        if (uni) ER_LOAD((size_t)(u.pm >> 3) * 36864 + col0);
#pragma unroll
        for (int am = 0; am < 4; ++am) { const int ai = am >> 1, m0 = (am & 1) * 2;
            u32x4 xr[4][2];
#pragma unroll
            for (int m = m0; m < m0 + 2; ++m)
#pragma unroll
                for (int bj = 0; bj < 2; ++bj) xr[m][bj] = *(const GAS u32x4*)(H + (size_t)(row0 + ai * 128 + m * 16) * D + col0 + bj * 128);
#pragma unroll
            for (int m = m0; m < m0 + 2; ++m) { const int r = row0 + ai * 128 + m * 16; float q = 0.f;
                if (!uni) ER_LOAD((size_t)row_batch(r) * 36864 + col0);
#pragma unroll
                for (int bj = 0; bj < 2; ++bj) { float x[8]; unpack8(xr[m][bj], x);
#pragma unroll
                    for (int n = 0; n < 2; ++n)
#pragma unroll
                        for (int j = 0; j < 4; ++j) { const float v = x[n * 4 + j] * rc[bj][n][j] + g[bj][n][j] * acc[ai][bj][m][n][j]; q += v * v; x[n * 4 + j] = v * hs[bj][n][j]; }
                    *(GAS u32x4*)(H + (size_t)r * D + col0 + bj * 128) = pack8(x); }
                q += __int_as_float(__builtin_amdgcn_ds_bpermute((ln ^ 16) << 2, __float_as_int(q))); q += __int_as_float(__builtin_amdgcn_ds_bpermute((ln ^ 32) << 2, __float_as_int(q)));
                if (fq == 0) (void)__hip_atomic_fetch_add(ssq + r, (ssq_t)(q * SSQ_SCALE + 0.5f), __ATOMIC_RELAXED, __HIP_MEMORY_SCOPE_AGENT); } }
#undef ER_LOAD
    }
};
struct EpiProj {
    static constexpr bool PERM = true;
    bf16_t* PA; bf16_t* PG; const ssq_t* ssq; const float* sb;
    struct Pre { ssq_t rs[8]; f32x4 sv[2][2]; };
    __device__ __forceinline__ Pre pre(const pg8::Unit& u, int wr, int wc, int fr, int fq) const {
        Pre p; const int row0 = u.pm * 256 + wr * 64 + fr, scol = u.pn * 256 + wc * 32 + 8 * fq;
#pragma unroll
        for (int i = 0; i < 8; ++i) p.rs[i] = *(const GAS ssq_t*)(ssq + row0 + (i >> 2) * 128 + (i & 3) * 16);
        const float* sp = sb + (size_t)(u.pm < 64 ? (u.pm >> 3) : 0) * SB_LD + scol;
#pragma unroll
        for (int bj = 0; bj < 2; ++bj)
#pragma unroll
            for (int n = 0; n < 2; ++n) p.sv[bj][n] = *(const GAS f32x4*)(sp + bj * 128 + 4 * n);
        return p;
    }
    __device__ __forceinline__ void operator()(const f32x4 (&acc)[2][2][4][2], const pg8::Unit& u, int wr, int wc, int fr, int fq, const Pre& p) const {
        const int row0 = u.pm * 256 + wr * 64 + fr, scol = u.pn * 256 + wc * 32 + 8 * fq;
        const int act = (u.pn >= 12) ? 2 : ((u.pn >= 6 && u.pn < 10) ? 1 : 0);
        const bool prod = u.pn < 4;
        bf16_t* P = u.pn >= 12 ? PG + (u.pn - 12) * 256 + wc * 32 + 8 * fq : (prod ? PA + u.pn * 128 + wc * 32 + 8 * fq : (u.pn < 6 ? PA + scol - 512 : PA + scol));
        const bool uni = u.pm < 64;
        float rs[8];
#pragma unroll
        for (int i = 0; i < 8; ++i) rs[i] = (float)p.rs[i] * SSQ_INV;
        f32x4 sv[2][2];
#pragma unroll
        for (int bj = 0; bj < 2; ++bj)
#pragma unroll
            for (int n = 0; n < 2; ++n) sv[bj][n] = p.sv[bj][n];
#pragma unroll
        for (int i = 0; i < 8; ++i) { const int ai = i >> 2, m = i & 3, r = row0 + ai * 128 + m * 16; const float rr = __builtin_amdgcn_rsqf(rs[i] * (1.f / D) + EPS); bf16_t* rowp = P + (size_t)r * 3072;
            if (!uni) { const float* sp = sb + (size_t)row_batch(r) * SB_LD + scol;
#pragma unroll
                for (int bj = 0; bj < 2; ++bj)
#pragma unroll
                    for (int n = 0; n < 2; ++n) sv[bj][n] = *(const GAS f32x4*)(sp + bj * 128 + 4 * n); }
            if (prod) { float v[8];
#pragma unroll
                for (int n = 0; n < 2; ++n)
#pragma unroll
                    for (int j = 0; j < 4; ++j) v[n * 4 + j] = (acc[ai][0][m][n][j] * rr + sv[0][n][j]) * (acc[ai][1][m][n][j] * rr + sv[1][n][j]);
                *(GAS u32x4*)rowp = pack8(v); }
            else
#pragma unroll
            for (int bj = 0; bj < 2; ++bj) { float v[8];
#pragma unroll
                for (int n = 0; n < 2; ++n)
#pragma unroll
                    for (int j = 0; j < 4; ++j) v[n * 4 + j] = acc[ai][bj][m][n][j] * rr + sv[bj][n][j];
                if (act == 1) {
#pragma unroll
                    for (int q = 0; q < 4; ++q) { const f32x2 o = gelu_pk((f32x2){v[2 * q], v[2 * q + 1]}); v[2 * q] = o.x; v[2 * q + 1] = o.y; } }
                else if (act == 2) {
#pragma unroll
                    for (int q = 0; q < 8; ++q) v[q] = fast_sigmoid(v[q]); }
                *(GAS u32x4*)(rowp + bj * 128) = pack8(v); } }
    }
};
struct EpiMix {
    static constexpr bool PERM = true;
    bf16_t* MgP; bf16_t* MgSv; const bf16_t* sg0; const float* ps0;
    struct Pre {}; __device__ __forceinline__ Pre pre(const pg8::Unit&, int, int, int, int) const { return Pre{}; }
    __device__ __forceinline__ void operator()(f32x4 (&acc)[2][2][4][2], const pg8::Unit& u, int wr, int wc, int fr, int fq, const Pre&) const {
        const int row0 = u.pm * 256 + wr * 64 + fr, col0 = u.pn * 256 + wc * 32 + 8 * fq, job = u.job;
        bf16_t* Mg = sel_ptr(u.pm < 64, MgP, MgSv);
        const bf16_t* gN = sg0 + (job == 0 ? 0 : (job == 1 ? 1024 : 2048));
        const bf16_t* gD = sg0 + (job == 0 ? 1024 : 2048);
        float sc[2][8];
#pragma unroll
        for (int bj = 0; bj < 2; ++bj) { const int c = col0 + bj * 128; const f32x4 p0 = *(const GAS f32x4*)(ps0 + c), p1 = *(const GAS f32x4*)(ps0 + c + 4);
            sc[bj][0] = p0[0]; sc[bj][1] = p0[1]; sc[bj][2] = p0[2]; sc[bj][3] = p0[3]; sc[bj][4] = p1[0]; sc[bj][5] = p1[1]; sc[bj][6] = p1[2]; sc[bj][7] = p1[3]; }
#pragma unroll
        for (int am = 0; am < 4; ++am) { const int ai = am >> 1, m0 = (am & 1) * 2;
            u32x4 nr[4][2], dr[4][2];
#pragma unroll
            for (int m = m0; m < m0 + 2; ++m)
#pragma unroll
                for (int bj = 0; bj < 2; ++bj) { const size_t r = (size_t)(row0 + ai * 128 + m * 16); nr[m][bj] = *(const GAS u32x4*)(gN + r * 3072 + col0 + bj * 128);
                    dr[m][bj] = job < 2 ? *(const GAS u32x4*)(gD + r * 3072 + col0 + bj * 128) : (u32x4){0u, 0u, 0u, 0u}; }
#pragma unroll
            for (int m = m0; m < m0 + 2; ++m) { const size_t r = (size_t)(row0 + ai * 128 + m * 16);
#pragma unroll
                for (int bj = 0; bj < 2; ++bj) { float n8[8], d8[8]; unpack8(nr[m][bj], n8); unpack8(dr[m][bj], d8);
                    if (job == 2) { float v[8];
#pragma unroll
                        for (int n = 0; n < 2; ++n)
#pragma unroll
                            for (int j = 0; j < 4; ++j) v[n * 4 + j] = acc[ai][bj][m][n][j] * n8[n * 4 + j] * sc[bj][n * 4 + j];
                        *(GAS u32x4*)(Mg + r * D + col0 + bj * 128) = pack8(v); }
                    else {
#pragma unroll
                        for (int n = 0; n < 2; ++n)
#pragma unroll
                            for (int j = 0; j < 4; ++j) { const float den = fmaxf(job == 0 ? d8[n * 4 + j] : d8[n * 4 + j] * sc[bj][n * 4 + j] * (sc[bj][n * 4 + j] < 0.f ? -1.f : 1.f), 1e-30f) * (job == 1 && sc[bj][n * 4 + j] < 0.f ? -1.f : 1.f);
                                acc[ai][bj][m][n][j] *= n8[n * 4 + j] * __builtin_amdgcn_rcpf(den); } } } } }
    }
};

#define XB_TMO      128
#define XB_XCNT(j)  (256  + 64 * (j))
#define XB_XSUB(j)  (1280 + 64 * (j))
#define XB_XGEN(j)  (2304 + 64 * (j))
#define XB_TOP      3328
#define XB_TOPGEN   3392
#define XCD_BAR_WORDS 3456
#define XB_SPIN_CAP (1u << 22)
__device__ __forceinline__ unsigned xb_ld(unsigned* p)              { return __hip_atomic_load(p, __ATOMIC_RELAXED, __HIP_MEMORY_SCOPE_AGENT); }
__device__ __forceinline__ unsigned xb_add(unsigned* p, unsigned v) { return __hip_atomic_fetch_add(p, v, __ATOMIC_RELAXED, __HIP_MEMORY_SCOPE_AGENT); }
__device__ __forceinline__ unsigned xb_xcc_id() { return (unsigned)__builtin_amdgcn_s_getreg((3 << 11) | 20) & 0xFu; }
#define XB_SPIN(cond, bar) do { unsigned _sp = 0; while (cond) { __builtin_amdgcn_s_sleep(1); \
    if ((++_sp & 255u) == 0u) { if (xb_ld(&(bar)[XB_TMO])) break; if (_sp > XB_SPIN_CAP) { atomicAdd(&(bar)[XB_TMO], 1u); break; } } } } while (0)
struct XcdBarrier { unsigned* bar; unsigned x; volatile LAS unsigned* st; };
__device__ __forceinline__ XcdBarrier xcd_barrier_post(unsigned* bar, volatile LAS unsigned* st) {
    XcdBarrier b; b.bar = bar; b.x = xb_xcc_id(); b.st = st;
    if (threadIdx.x == 0) (void)xb_add(&bar[XB_XCNT(b.x)], 1u);
    return b;
}
__device__ __forceinline__ void xcd_barrier_complete(unsigned* bar, unsigned x, unsigned& nloc, unsigned& nx) {
    const unsigned G = gridDim.x * gridDim.y * gridDim.z;
    unsigned sum, cnt, mine, sp = 0u;
    for (;;) {
        sum = 0u; cnt = 0u; mine = 0u;
#pragma unroll
        for (unsigned j = 0; j < 16; ++j) { const unsigned c = xb_ld(&bar[XB_XCNT(j)]); sum += c; cnt += (c > 0u) ? 1u : 0u; mine = (j == x) ? c : mine; }
        if (sum == G) break;
        __builtin_amdgcn_s_sleep(1);
        if ((++sp & 255u) == 0u) { if (xb_ld(&bar[XB_TMO])) break; if (sp > XB_SPIN_CAP) { atomicAdd(&bar[XB_TMO], 1u); break; } }
    }
    nloc = mine > 0u ? mine : 1u; nx = cnt > 0u ? cnt : 1u;
}
__device__ __forceinline__ void xcd_barrier(const XcdBarrier& b) {
    asm volatile("s_waitcnt vmcnt(0)" ::: "memory");
    __syncthreads();
    if (threadIdx.x == 0) {
        unsigned* bar = b.bar;
        __builtin_amdgcn_s_waitcnt(0);
        unsigned nloc = b.st[0], nx = b.st[1];
        if (nloc == 0u) { xcd_barrier_complete(bar, b.x, nloc, nx); b.st[0] = nloc; b.st[1] = nx; }
        const unsigned old = xb_add(&bar[XB_XSUB(b.x)], 1u);
        const unsigned gen = old / nloc;
        if (old + 1u == (gen + 1u) * nloc) {
            __builtin_amdgcn_fence(__ATOMIC_RELEASE, "agent");
            asm volatile("s_waitcnt vmcnt(0)" ::: "memory");
            const unsigned og = xb_add(&bar[XB_TOP], 1u);
            const unsigned tg = og / nx;
            if (og + 1u == (tg + 1u) * nx) xb_add(&bar[XB_TOPGEN], 1u);
            else XB_SPIN(xb_ld(&bar[XB_TOPGEN]) == tg, bar);
            __builtin_amdgcn_fence(__ATOMIC_ACQUIRE, "agent");
            xb_add(&bar[XB_XGEN(b.x)], 1u);
            asm volatile("s_waitcnt vmcnt(0)" ::: "memory");
        } else {
            XB_SPIN(xb_ld(&bar[XB_XGEN(b.x)]) == gen, bar);
            __builtin_amdgcn_fence(__ATOMIC_ACQUIRE, "agent");
            asm volatile("s_waitcnt vmcnt(0)" ::: "memory");
        }
    }
    __syncthreads();
}

__device__ __forceinline__ int opaque_lane() { int l; asm volatile("v_mbcnt_lo_u32_b32 %0, -1, 0\n\tv_mbcnt_hi_u32_b32 %0, -1, %0" : "=v"(l)); return l; }
__device__ __forceinline__ void dep_signal(unsigned* cnt, bool leader) {
    if (leader) { __builtin_amdgcn_fence(__ATOMIC_RELEASE, "agent"); asm volatile("s_waitcnt vmcnt(0)" ::: "memory"); (void)xb_add(cnt, 1u); }
}
__device__ __forceinline__ void dep_wait(unsigned* cnt, unsigned need, bool leader) {
    if (leader) { unsigned sp = 0; while (xb_ld(cnt) < need) { __builtin_amdgcn_s_sleep(2); if (++sp > (1u << 22)) break; }
        __builtin_amdgcn_fence(__ATOMIC_ACQUIRE, "agent"); asm volatile("s_waitcnt vmcnt(0)" ::: "memory"); }
    __syncthreads();
}
struct Args { const float* in[24]; float* out; unsigned char* ws; int ph_lo, ph_hi; };
typedef const __attribute__((address_space(4))) Args* ArgsP;
enum { I_XP = 0, I_XS, I_SCONV, I_SPOOL, I_CP, I_CS, I_NORMG, I_WADA, I_BADA, I_W1GU, I_W1DN, I_W2GU, I_W2DN, I_WIN, I_CONVW, I_WOA, I_LNG, I_WS, I_BS, I_WOB, I_POOLW, I_POOLS, I_WO, I_FNG };
constexpr int NPH = 3 + 8 * DEPTH + 1;

__device__ __forceinline__ void conv_item(const float* W, int K, int N, bf16_t* WT, int ldk, int mode, int rowoff, LAS float* scr, int item, int lane) {
    const int nblk = N / 32, kb = item / nblk, nb = item % nblk, k0 = 64 * kb, n0 = 32 * nb;
    const GAS float* rowp = (const GAS float*)W + (size_t)k0 * N + n0;
    const unsigned loff = (unsigned)((lane >> 5) * N + (lane & 31));
    float tv[32];
#pragma unroll
    for (int i = 0; i < 32; ++i) tv[i] = (rowp + (size_t)(2 * i) * N)[loff];
#pragma unroll
    for (int i = 0; i < 32; ++i) scr[(2 * i + (lane >> 5)) * 33 + (lane & 31)] = tv[i];
    LDS_WAIT();
    const int c = lane & 7;
#pragma unroll
    for (int j = 0; j < 4; ++j) { const int n = (lane >> 3) + 8 * j; const LAS float* s = scr + (8 * c) * 33 + n;
        u32x4 o; o.x = cvt_pk_bf16(s[0 * 33], s[1 * 33]); o.y = cvt_pk_bf16(s[2 * 33], s[3 * 33]); o.z = cvt_pk_bf16(s[4 * 33], s[5 * 33]); o.w = cvt_pk_bf16(s[6 * 33], s[7 * 33]);
        int nn = n0 + n;
        if (mode == 1) { const int half = nn >= DFF ? 1 : 0, jj = nn - half * DFF; nn = (jj >> 7) * 256 + half * 128 + (jj & 127); }
        if (mode == 2) { if (nn < 512) nn = (nn >> 7) * 256 + (nn & 127); else if (nn < 1024) nn = 512 + nn; else if (nn < 1536) { const int jj = nn - 1024; nn = (jj >> 7) * 256 + 128 + (jj & 127); } }
        *(GAS u32x4*)(WT + (size_t)(rowoff + nn) * ldk + k0 + 8 * c) = o; }
    LDS_WAIT();
}
constexpr int IT_GU = 16 * 176, IT_DN = 44 * 32, IT_IN = 16 * 192, IT_OA = 8 * 32, IT_PL = 64, IT_WO = 16 * 32, IT_ADA = 16 * 288;
constexpr int IT_LAYER = 2 * IT_GU + 2 * IT_DN + IT_IN + 2 * IT_OA + IT_PL + IT_WO + IT_ADA;

__device__ __forceinline__ void phase_prologue(ArgsP a, LAS unsigned char* lds, int gw, int NGW, int wave, int lane) {
    unsigned char* ws = a->ws;
    LAS float* scr = (LAS float*)(lds + wave * 16384);
    for (int it = gw; it < DEPTH * IT_LAYER; it += NGW) {
        const int l = it / IT_LAYER; int r = it - l * IT_LAYER;
        bf16_t* LW = (bf16_t*)(ws + WS_W + (size_t)l * LW_SIZE);
        if (r < IT_GU) { conv_item(a->in[I_W1GU] + (size_t)l * 1024 * 5632, 1024, 5632, LW + LW_GU1 / 2, 1024, 1, 0, scr, r, lane); continue; } r -= IT_GU;
        if (r < IT_DN) { conv_item(a->in[I_W1DN] + (size_t)l * 2816 * 1024, 2816, 1024, LW + LW_DN1 / 2, 2816, 0, 0, scr, r, lane); continue; } r -= IT_DN;
        if (r < IT_GU) { conv_item(a->in[I_W2GU] + (size_t)l * 1024 * 5632, 1024, 5632, LW + LW_GU2 / 2, 1024, 1, 0, scr, r, lane); continue; } r -= IT_GU;
        if (r < IT_DN) { conv_item(a->in[I_W2DN] + (size_t)l * 2816 * 1024, 2816, 1024, LW + LW_DN2 / 2, 2816, 0, 0, scr, r, lane); continue; } r -= IT_DN;
        if (r < IT_IN) { conv_item(a->in[I_WIN] + (size_t)l * 1024 * 6144, 1024, 6144, LW + LW_IN / 2, 1024, 2, 0, scr, r, lane); continue; } r -= IT_IN;
        if (r < IT_OA) { conv_item(a->in[I_WOA] + (size_t)l * 512 * 1024, 512, 1024, LW + LW_OA / 2, 512, 0, 0, scr, r, lane); continue; } r -= IT_OA;
        if (r < IT_OA) { conv_item(a->in[I_WOB] + (size_t)l * 512 * 1024, 512, 1024, LW + LW_OB / 2, 512, 0, 0, scr, r, lane); continue; } r -= IT_OA;
        if (r < IT_PL) { const int g = r >> 4; conv_item(a->in[I_POOLW] + (size_t)(l * 4 + g) * 128 * 256, 128, 256, LW + LW_PL / 2, 128, 0, g * 256, scr, r & 15, lane); continue; } r -= IT_PL;
        if (r < IT_WO) { conv_item(a->in[I_WO] + (size_t)l * 1024 * 1024, 1024, 1024, LW + LW_WO / 2, 1024, 0, 0, scr, r, lane); continue; } r -= IT_WO;
        conv_item(a->in[I_WADA] + (size_t)l * 1024 * 9216, 1024, 9216, (bf16_t*)(ws + WS_ADAW), 1024, 0, l * 9216, scr, r, lane);
    }
    const int gt = gw * 64 + lane, NGT = NGW * 64;
    { GAS unsigned* CA = (GAS unsigned*)(ws + WS_CA);
      for (int i = gt; i < 256 * 512; i += NGT) { const int b = i >> 9, k = (i & 511) * 2; float v0 = 0.f, v1 = 0.f;
        if (b < NBATCH) { const float* c = b < 8 ? a->in[I_CP] + (size_t)b * D : a->in[I_CS] + (size_t)(b - 8) * D; v0 = fast_silu(c[k]); v1 = fast_silu(c[k + 1]); }
        CA[i] = cvt_pk_bf16(v0, v1); } }
    { const GAS f32x2* sp = (const GAS f32x2*)a->in[I_SPOOL]; GAS unsigned* hp = (GAS unsigned*)(ws + WS_HISTP);
      for (int i = gt; i < DEPTH * 128 * 15 * 256; i += NGT) { const f32x2 v = sp[i]; hp[i] = cvt_pk_bf16(v.x, v.y); }
      const GAS f32x2* sc = (const GAS f32x2*)a->in[I_SCONV]; GAS unsigned* hc = (GAS unsigned*)(ws + WS_HISTC);
      for (int i = gt; i < DEPTH * 128 * 2 * 256; i += NGT) { const f32x2 v = sc[i]; hc[i] = cvt_pk_bf16(v.x, v.y); } }
    for (int i = gt; i < DEPTH * 8 * 128 * 64; i += NGT) { const int s = (i & 63) * 2, t = (i >> 6) & 127, lh = i >> 13, l = lh >> 3;
        const float* W = a->in[I_WS] + (size_t)lh * 128 * 128; bf16_t* LW = (bf16_t*)(ws + WS_W + (size_t)l * LW_SIZE);
        const float w0 = W[t * 128 + s], w1 = W[t * 128 + s + 1];
        ((GAS unsigned*)(LW + LW_TRIL / 2))[(size_t)(lh & 7) * 8192 + t * 64 + (s >> 1)] = cvt_pk_bf16(s <= t ? w0 : 0.f, s + 1 <= t ? w1 : 0.f);
        const int t8 = t & 7, s8 = s & 7; const bool same = (t >> 3) == (s >> 3);
        const float z0 = (same && s8 <= t8) ? W[t8 * 128 + s8] : 0.f, z1 = (same && s8 + 1 <= t8) ? W[t8 * 128 + s8 + 1] : 0.f;
        ((GAS unsigned*)(LW + LW_SAMP / 2))[(size_t)(lh & 7) * 8192 + t * 64 + (s >> 1)] = cvt_pk_bf16(z0, z1); }
}

__device__ __forceinline__ void phase_prep0(ArgsP a, int gw, int NGW, int lane) {
    const float* MOD = (const float*)(a->ws + WS_MOD); bf16_t* H = (bf16_t*)(a->ws + WS_H); ssq_t* SSQ = (ssq_t*)(a->ws + WS_SSQ);
    for (int row = gw; row < T; row += NGW) {
        const GAS f32x4* xr = (const GAS f32x4*)(row < TP ? a->in[I_XP] + (size_t)row * D : a->in[I_XS] + (size_t)(row - TP) * D) + lane;
        const float* mrow = MOD + (size_t)row_batch(row) * 36864 + D;
        GAS u32x2* o = (GAS u32x2*)(H + (size_t)row * D) + lane;
        float s = 0.f;
#pragma unroll
        for (int j = 0; j < 4; ++j) { const f32x4 v = xr[64 * j]; s += (v.x * v.x + v.y * v.y) + (v.z * v.z + v.w * v.w);
            const f32x4 h = v * *(const GAS f32x4*)(mrow + 4 * lane + 256 * j); u32x2 w; w.x = cvt_pk_bf16(h.x, h.y); w.y = cvt_pk_bf16(h.z, h.w); o[64 * j] = w; }
        s = wave_sum(s, lane);
        if (lane == 0) SSQ[row] = (ssq_t)(s * SSQ_SCALE + 0.5f);
    }
}
__device__ __forceinline__ void phase_final(ArgsP a, int gw, int NGW, int lane) {
    const bf16_t* X = (const bf16_t*)(a->ws + WS_H); const float* g = a->in[I_FNG]; const ssq_t* SSQ = (const ssq_t*)(a->ws + WS_SSQ) + (size_t)12 * T;
    f32x4 gv[4];
#pragma unroll
    for (int j = 0; j < 4; ++j) gv[j] = *(const GAS f32x4*)(g + 4 * lane + 256 * j);
    for (int row = gw; row < T; row += NGW) {
        const GAS u32x2* xr = (const GAS u32x2*)(X + (size_t)row * D) + lane;
        const float rstd = row_rstd(SSQ, row);
        GAS f32x4* o = (GAS f32x4*)(a->out + (size_t)row * D) + lane;
#pragma unroll
        for (int j = 0; j < 4; ++j) { const u32x2 w = xr[64 * j]; const f32x4 xv = (f32x4){bf_lo(w.x), bf_hi(w.x), bf_lo(w.y), bf_hi(w.y)}; o[64 * j] = (xv * rstd) * gv[j]; }
    }
}

__device__ __forceinline__ void gmlp_unit(ArgsP a, LAS unsigned char* lds, int l, int c, int wave, int lane) {
    const bf16_t* P = (const bf16_t*)(a->ws + WS_PA); bf16_t* Y = (bf16_t*)(a->ws + WS_YAB); float* out = a->out;
    const bf16_t* LW = (const bf16_t*)(a->ws + WS_W + (size_t)l * LW_SIZE);
    const int r0 = 128 * c; const bool samp = c >= 128;
    LAS bf16_t* vT = (LAS bf16_t*)lds;
    bf16x8 wfr[20];
    { const int fr = lane & 15, fq = lane >> 4; const bf16_t* Wh = LW + (samp ? LW_SAMP : LW_TRIL) / 2 + (size_t)wave * 128 * 128 + fr * 128 + 8 * fq;
      int wi = 0;
#pragma unroll
      for (int ks = 0; ks < 4; ++ks)
#pragma unroll
          for (int mt = 0; mt < 8; ++mt) if (mt >= 2 * ks) { wfr[wi] = *(const GAS bf16x8*)(Wh + (16 * mt) * 128 + 32 * ks); ++wi; } }
    { float lng[8];
      { const f32x4 g0 = *(const GAS f32x4*)(a->in[I_LNG] + l * 512 + 8 * lane), g1 = *(const GAS f32x4*)(a->in[I_LNG] + l * 512 + 8 * lane + 4);
        lng[0] = g0[0]; lng[1] = g0[1]; lng[2] = g0[2]; lng[3] = g0[3]; lng[4] = g1[0]; lng[5] = g1[1]; lng[6] = g1[2]; lng[7] = g1[3]; }
      const bf16_t* Pw = P + (size_t)(r0 + wave * 16) * 3072; const unsigned l8 = 8u * (unsigned)lane;
      u32x4 raw[16];
#pragma unroll
      for (int i = 0; i < 16; ++i) raw[i] = *(const GAS u32x4*)(Pw + i * 3072 + 2048 + l8);
#pragma unroll
      for (int i = 0; i < 16; ++i) { const int rl = wave * 16 + i, row = r0 + rl; float v[8];
        unpack8(raw[i], v);
        float s = 0.f;
#pragma unroll
        for (int j = 0; j < 8; ++j) s += v[j];
        const float mean = wave_sum(s, lane) * (1.f / 512.f); float q = 0.f;
#pragma unroll
        for (int j = 0; j < 8; ++j) { v[j] -= mean; q += v[j] * v[j]; }
        const float rstd = __builtin_amdgcn_rsqf(wave_sum(q, lane) * (1.f / 512.f) + EPS);
#pragma unroll
        for (int j = 0; j < 8; ++j) v[j] = v[j] * rstd * lng[j];
        if (samp) { float* o = out + O_V + (size_t)l * (128 * 8 * 512) + (size_t)(row - TP) * 512;
            *(GAS f32x4*)(o + l8) = (f32x4){v[0], v[1], v[2], v[3]}; *(GAS f32x4*)(o + 4 + l8) = (f32x4){v[4], v[5], v[6], v[7]}; }
        const u32x4 pk = pack8(v);
        LAS bf16_t* d = vT + (8 * lane) * VT_PITCH + ((((rl >> 3) ^ lane) & 15) << 3) + (rl & 7);
        d[0 * VT_PITCH] = (bf16_t)(pk.x & 0xffff); d[1 * VT_PITCH] = (bf16_t)(pk.x >> 16); d[2 * VT_PITCH] = (bf16_t)(pk.y & 0xffff); d[3 * VT_PITCH] = (bf16_t)(pk.y >> 16);
        d[4 * VT_PITCH] = (bf16_t)(pk.z & 0xffff); d[5 * VT_PITCH] = (bf16_t)(pk.z >> 16); d[6 * VT_PITCH] = (bf16_t)(pk.w & 0xffff); d[7 * VT_PITCH] = (bf16_t)(pk.w >> 16); }
    }
    __syncthreads();
    { const int h = wave, fr = lane & 15, fq = lane >> 4;
      f32x4 acc[8][4];
#pragma unroll
      for (int mt = 0; mt < 8; ++mt)
#pragma unroll
          for (int nt = 0; nt < 4; ++nt) acc[mt][nt] = (f32x4){0.f, 0.f, 0.f, 0.f};
      int wi = 0;
#pragma unroll
      for (int ks = 0; ks < 4; ++ks) { bf16x8 vf[4];
#pragma unroll
          for (int nt = 0; nt < 4; ++nt) { const int dd = h * 64 + 16 * nt + fr; vf[nt] = *(const LAS bf16x8*)(vT + dd * VT_PITCH + ((((4 * ks + fq) ^ (dd >> 3)) & 15) << 3)); }
#pragma unroll
          for (int mt = 0; mt < 8; ++mt) if (mt >= 2 * ks) { const bf16x8 wf = wfr[wi]; ++wi;
#pragma unroll
              for (int nt = 0; nt < 4; ++nt) acc[mt][nt] = __builtin_amdgcn_mfma_f32_16x16x32_bf16(vf[nt], wf, acc[mt][nt], 0, 0, 0); } }
      const float* bs = a->in[I_BS] + (size_t)(l * 8 + h) * 128;
#pragma unroll
      for (int mt = 0; mt < 8; ++mt) { const int t = 16 * mt + fr, row = r0 + t; const float bias = bs[samp ? (t & 7) : t];
          u32x2 ur[4];
#pragma unroll
          for (int nt = 0; nt < 4; ++nt) ur[nt] = *(const GAS u32x2*)(P + (size_t)row * 3072 + 1536 + h * 64 + 16 * nt + 4 * fq);
#pragma unroll
          for (int nt = 0; nt < 4; ++nt) { const int d = h * 64 + 16 * nt + 4 * fq;
              u32x2 w; w.x = cvt_pk_bf16((acc[mt][nt][0] + bias) * bf_lo(ur[nt].x), (acc[mt][nt][1] + bias) * bf_hi(ur[nt].x));
              w.y = cvt_pk_bf16((acc[mt][nt][2] + bias) * bf_lo(ur[nt].y), (acc[mt][nt][3] + bias) * bf_hi(ur[nt].y));
              *(GAS u32x2*)(Y + (size_t)row * D + 512 + d) = w; } }
    }
    __syncthreads();
}
__device__ __forceinline__ void convpool_unit(ArgsP a, int l, int cu, int wave, int lane) {
    const bf16_t* P = (const bf16_t*)(a->ws + WS_PA); bf16_t* Y = (bf16_t*)(a->ws + WS_YAB); bf16_t* YC = (bf16_t*)(a->ws + WS_YC); float* out = a->out;
    const int r0 = 32 * cu + 4 * wave; const bool samp = r0 >= TP;
    const int tpos0 = samp ? ((r0 - TP) & 7) : (r0 & 2047), sq = samp ? ((r0 - TP) >> 3) : (r0 >> 11), L = samp ? 8 : 2048; const unsigned d = 8u * (unsigned)lane;
    const bf16_t* Pr = P + (size_t)r0 * 3072;
    bf16_t* Yr = Y + (size_t)r0 * D; bf16_t* YCr = YC + (size_t)r0 * 512;
    { u32x4 xa[6], bg[4];
      const bf16_t* hc = (const bf16_t*)(a->ws + WS_HISTC) + (size_t)(l * 128 + sq) * 2 * 512;
#pragma unroll
      for (int k = 0; k < 6; ++k) { const int tp = tpos0 - 2 + k;
          if (tp >= 0) xa[k] = *(const GAS u32x4*)(Pr + (k - 2) * 3072 + d);
          else if (samp) xa[k] = *(const GAS u32x4*)(hc + (2 + tp) * 512 + d);
          else xa[k] = (u32x4){0u, 0u, 0u, 0u}; }
#pragma unroll
      for (int j = 0; j < 4; ++j) bg[j] = *(const GAS u32x4*)(Pr + j * 3072 + 512 + d);
      float cw[3][8];
#pragma unroll
      for (int k = 0; k < 3; ++k) { const float* cwp = a->in[I_CONVW] + (size_t)(l * 3 + k) * 512; const f32x4 c0 = *(const GAS f32x4*)(cwp + d), c1 = *(const GAS f32x4*)(cwp + 4 + d);
          cw[k][0] = c0[0]; cw[k][1] = c0[1]; cw[k][2] = c0[2]; cw[k][3] = c0[3]; cw[k][4] = c1[0]; cw[k][5] = c1[1]; cw[k][6] = c1[2]; cw[k][7] = c1[3]; }
      float ci[6][8];
#pragma unroll
      for (int k = 0; k < 6; ++k) unpack8(xa[k], ci[k]);
#pragma unroll
      for (int j = 0; j < 4; ++j) { float b8[8], ya[8]; unpack8(bg[j], b8);
#pragma unroll
          for (int q = 0; q < 8; ++q) ya[q] = b8[q] * (cw[0][q] * ci[j][q] + cw[1][q] * ci[j + 1][q] + cw[2][q] * ci[j + 2][q]);
          *(GAS u32x4*)(Yr + j * D + d) = pack8(ya); }
      if (tpos0 == L - 4) {
#pragma unroll
          for (int j = 2; j < 4; ++j) { float* o = out + (samp ? O_CS : O_CP) + ((size_t)(l * (samp ? 128 : 8) + sq) * 2 + (j - 2)) * 512;
              *(GAS f32x4*)(o + d) = (f32x4){ci[j + 2][0], ci[j + 2][1], ci[j + 2][2], ci[j + 2][3]}; *(GAS f32x4*)(o + 4 + d) = (f32x4){ci[j + 2][4], ci[j + 2][5], ci[j + 2][6], ci[j + 2][7]}; } }
    }
    { const int w = 2 << (lane >> 4);
      const bf16_t* hp = (const bf16_t*)(a->ws + WS_HISTP) + (size_t)(l * 128 + sq) * 15 * 512;
      u32x4 raw[19];
#pragma unroll
      for (int i = 0; i < 19; ++i) { const int tp = tpos0 + 3 - i; raw[i] = (u32x4){0u, 0u, 0u, 0u};
          if (i < 5 || i < w + 3) {
              if (tp >= 0) raw[i] = *(const GAS u32x4*)(Pr + (3 - i) * 3072 + 2560 + d);
              else if (samp) raw[i] = *(const GAS u32x4*)(hp + (15 + tp) * 512 + d); } }
      float o[4][8], pc[4][8];
#pragma unroll
      for (int j = 0; j < 4; ++j)
#pragma unroll
          for (int q = 0; q < 8; ++q) { o[j][q] = 0.f; pc[j][q] = 0.f; }
#pragma unroll
      for (int i = 0; i < 19; ++i) { float p8[8]; unpack8(raw[i], p8);
#pragma unroll
          for (int j = 0; j < 4; ++j) { const int ii = i - 3 + j;
              if (ii >= 0 && ii < 16) { const float m = ii < w ? 1.f : 0.f;
#pragma unroll
                  for (int q = 0; q < 8; ++q) o[j][q] += m * p8[q]; }
              if (ii == 0) {
#pragma unroll
                  for (int q = 0; q < 8; ++q) pc[j][q] = p8[q]; } } }
#pragma unroll
      for (int j = 0; j < 4; ++j) { const int tpos = tpos0 + j; const float inv = 1.0f / (float)(samp ? w : (tpos + 1 < w ? tpos + 1 : w)); float yc[8];
#pragma unroll
          for (int q = 0; q < 8; ++q) yc[q] = o[j][q] * inv - pc[j][q];
          *(GAS u32x4*)(YCr + j * 512 + d) = pack8(yc);
          if (samp) { float* oo = out + O_PS + ((size_t)(l * 128 + sq) * 15 + 7 + tpos) * 512;
              *(GAS f32x4*)(oo + d) = (f32x4){pc[j][0], pc[j][1], pc[j][2], pc[j][3]}; *(GAS f32x4*)(oo + 4 + d) = (f32x4){pc[j][4], pc[j][5], pc[j][6], pc[j][7]}; }
          else if (tpos >= 2048 - 15) { float* oo = out + O_PP + ((size_t)(l * 8 + sq) * 15 + (tpos - (2048 - 15))) * 512;
              *(GAS f32x4*)(oo + d) = (f32x4){pc[j][0], pc[j][1], pc[j][2], pc[j][3]}; *(GAS f32x4*)(oo + 4 + d) = (f32x4){pc[j][4], pc[j][5], pc[j][6], pc[j][7]}; } }
      if (samp && tpos0 == 0) {
#pragma unroll
          for (int i = 0; i < 7; ++i) { const float* sp = a->in[I_SPOOL] + ((size_t)(l * 128 + sq) * 15 + 8 + i) * 512; float* o2 = out + O_PS + ((size_t)(l * 128 + sq) * 15 + i) * 512;
              *(GAS f32x4*)(o2 + d) = *(const GAS f32x4*)(sp + d); *(GAS f32x4*)(o2 + 4 + d) = *(const GAS f32x4*)(sp + 4 + d); } }
    }
}

__global__ void __launch_bounds__(512, 2) fwd(Args a_) {
    extern __shared__ __attribute__((aligned(16))) unsigned char lds_raw[];
    LAS unsigned char* lds = (LAS unsigned char*)lds_raw;
    const int G = gridDim.x, bx = blockIdx.x;
#if ONE_LAUNCH
    volatile LAS unsigned* MISC = (volatile LAS unsigned*)(lds + MISC_OFF);
    if (threadIdx.x < 64) MISC[threadIdx.x] = 0u;
    __syncthreads();
    (void)xcd_barrier_post((unsigned*)(a_.ws + WS_CTL) + 4096, MISC + 8);
#endif
    const int ph_lo = a_.ph_lo, ph_hi = a_.ph_hi;
    const int wave0 = __builtin_amdgcn_readfirstlane(threadIdx.x >> 6);
#if ONE_LAUNCH
    if (ph_lo > ph_hi) cg::this_grid().sync();
#endif
    int redo = 0;
    for (int ph = ph_lo; ph < ph_hi; ++ph) {
        ArgsP a = (ArgsP)__builtin_amdgcn_kernarg_segment_ptr(); asm volatile("" : "+s"(a));
        int wave = wave0; asm volatile("" : "+s"(wave));
#define TID() (wave * 64 + opaque_lane())
        unsigned char* ws = a->ws; asm volatile("" : "+s"(ws));
        const int gw = bx * 8 + wave, NGW = G * 8;
        float* MOD = (float*)(ws + WS_MOD); ssq_t* SSQ = (ssq_t*)(ws + WS_SSQ); float* SB = (float*)(ws + WS_SB);
        constexpr size_t TSTEP1K = (size_t)256 * 1024 * 2;
        if (ph == 0) phase_prologue(a, lds, gw, NGW, wave, opaque_lane());
        else if (ph == 1) {
            pg8::Gemm g{(const bf16_t*)(ws + WS_CA), (const bf16_t*)(ws + WS_ADAW), 1024, 1024, 1024, 0, 0, 0}; pg8::StaticOrder S; S.init(1, 36864 / 256, G, bx);
            EpiAda E{MOD, a->in[I_BADA], a->in[I_NORMG], (bf16_t*)(ws + WS_SH)};
            pg8::gemm_phase<EpiAda, pg8::StaticOrder>(lds, g, S, E, TID());
        } else if (ph == 2) {
            for (int sidx = 0; sidx < 3; ++sidx) { const int tid2 = TID();
                pg8::Gemm g{(const bf16_t*)(ws + WS_SH) + (size_t)sidx * 256 * 1024, (const bf16_t*)(ws + WS_W + (sidx == 0 ? LW_GU1 : (sidx == 1 ? LW_IN : LW_GU2))), 1024, 1024, 1024, 0, 3 * TSTEP1K, LW_SIZE};
                pg8::StaticOrder S; S.init(0, 4, sidx == 1 ? 24 : 22, G, bx, sidx == 0 ? 0 : (sidx == 1 ? 88 : 184), sidx == 0 ? 88 : (sidx == 1 ? 96 : 72), 0, 0);
                EpiSB E{SB, sidx == 0 ? 0 : (sidx == 1 ? 5632 : 11776)};
                pg8::gemm_phase<EpiSB, pg8::StaticOrder>(lds, g, S, E, tid2);
            }
            phase_prep0(a, gw, NGW, opaque_lane());
        } else if (ph == NPH - 1) phase_final(a, gw, NGW, opaque_lane());
        else {
            const int l = (ph - 3) >> 3, k = (ph - 3) & 7;
            const bf16_t* LW = (const bf16_t*)(ws + WS_W + (size_t)l * LW_SIZE);
            unsigned* DEP = (unsigned*)(ws + WS_CTL) + 8192 + 64 * 2 * (l * 8 + k);
            bf16_t* GSv = (bf16_t*)(ws + WS_GS) - (size_t)TP * DFF; bf16_t* MGSv = (bf16_t*)(ws + WS_MGS) - (size_t)TP * D;
            if (k == 3) {
                if (bx < T / 128) gmlp_unit(a, lds, l, bx, wave, opaque_lane());
                else for (int u = bx - T / 128; u < T / 32; u += G - T / 128) convpool_unit(a, l, u, wave, opaque_lane());
            } else {
                const bool lastl = (l == DEPTH - 1);
                const int nsteps = (k == 0) ? 3 : (k == 2) ? 3 : (k == 6) ? (lastl ? 6 : 4) : 1;
                for (int st = 0; st < nsteps; ++st) {
                    int ek = 0, samp = 0, jl = l, jsub = 0, nN = 4, cu_off = 0, cu_cnt = G, skc = 0, skr = 0, sig = -1, wt = -1, gu2 = 0, ri0 = 0, rend = 1 << 20; unsigned wneed = 16u;
                    if (k == 0) { if (st == 0) { if (l > 0) { ek = 2; samp = 1; jl = l - 1; jsub = 2; cu_cnt = 16; sig = 0; } }
                                  else if (st == 1) { ek = 1; nN = 22; if (l > 0) { skc = 16; skr = 3; } }
                                  else { ek = 1; samp = 1; nN = 22; cu_off = 168; cu_cnt = 88; if (l > 0) wt = 0; } }
                    else if (k == 1) { ek = 2; jsub = 0; }
                    else if (k == 2) { if (st == 0) { ek = 2; samp = 1; jsub = 0; cu_cnt = 16; sig = 0; }
                                       else if (st == 1) { ek = 3; nN = 24; skc = 16; skr = 3; }
                                       else { ek = 3; samp = 1; nN = 24; cu_off = 160; cu_cnt = 96; wt = 0; } }
                    else if (k == 4) { ek = 4; }
                    else if (k == 5) { ek = 2; jsub = 1; }
                    else if (k == 6 && !lastl) { if (st == 0) { ek = 4; samp = 1; cu_cnt = 16; sig = 0; }
                                       else if (st == 1) { ek = 2; samp = 1; jsub = 1; cu_cnt = 16; wt = 0; sig = 1; }
                                       else if (st == 2) { ek = 1; gu2 = 1; nN = 22; skc = 16; skr = 4; }
                                       else { ek = 1; gu2 = 1; samp = 1; nN = 22; cu_off = 168; cu_cnt = 88; wt = 1; } }
                    else if (k == 6) {
                                       if (st == 0) { ek = 4; samp = 1; cu_cnt = 16; sig = 0; }
                                       else if (st == 1) { ek = 2; samp = 1; jsub = 1; cu_cnt = 16; wt = 0; sig = 1; }
                                       else if (st == 2) { ek = 1; gu2 = 1; nN = 22; skc = 16; skr = 5; rend = 3; }
                                       else if (st == 3) { ek = 1; gu2 = 1; samp = 1; nN = 22; cu_off = 168; cu_cnt = 88; wt = 1; sig = 2; }
                                       else if (st == 4) { ek = 1; gu2 = 1; nN = 22; skc = 16; skr = 5; ri0 = 3; }
                                       else { ek = 2; samp = 1; jsub = 2; cu_cnt = 16; wt = 2; wneed = 88u; } }
                    else { ek = 2; jsub = 2; }
                    if (ek == 0) continue;
                    pg8::StaticOrder S; S.init(samp ? 64 : 0, samp ? 4 : 64, nN, G, bx, cu_off, cu_cnt, skc, skr, ri0, rend);
                    pg8::Unit u0; const bool mine = S.next(0, u0);
                    const bool leader = (TID() == 0);
                    if (wt >= 0 && mine) dep_wait(DEP + 64 * wt, wneed, leader);
                    const bf16_t* JW = (const bf16_t*)(ws + WS_W + (size_t)jl * LW_SIZE);
                    if (ek == 1) {
                        pg8::Gemm g{(const bf16_t*)(ws + WS_H), LW + (gu2 ? LW_GU2 : LW_GU1) / 2, 1024, 1024, 1024, 0, TSTEP1K, 0};
                        EpiSwiglu E{(bf16_t*)(ws + WS_G), GSv, SSQ + (size_t)(3 * l + (gu2 ? 2 : 0)) * T, SB + l * SB_LAYER + (gu2 ? 11776 : 0)};
                        pg8::gemm_phase<EpiSwiglu, pg8::StaticOrder>(lds, g, S, E, TID());
                    } else if (ek == 2) {
                        pg8::Gemm g; float sc;
                        if (jsub == 1) { g = pg8::Gemm{samp ? (const bf16_t*)MGSv : (const bf16_t*)(ws + WS_MG), JW + LW_WO / 2, 1024, 1024, 1024, 0, TSTEP1K, 0}; sc = 1.0f; }
                        else { g = pg8::Gemm{samp ? (const bf16_t*)GSv : (const bf16_t*)(ws + WS_G), JW + (jsub == 0 ? LW_DN1 : LW_DN2) / 2, DFF, DFF, DFF, 0, (size_t)256 * DFF * 2, 0}; sc = 0.5f; }
                        const int nsub = jsub == 2 ? 0 : jsub + 1, nl = jsub == 2 ? (jl == DEPTH - 1 ? jl : jl + 1) : jl; const int fin = (jsub == 2 && jl == DEPTH - 1) ? 1 : 0;
                        EpiResid E{MOD + jl * NADA + (jsub * 3 + 2) * D, MOD + jl * NADA + (jsub * 3 + 1) * D, MOD + nl * NADA + (nsub * 3 + 1) * D, (bf16_t*)(ws + WS_H), SSQ + (size_t)(3 * jl + jsub + 1) * T, sc, fin};
                        pg8::gemm_phase<EpiResid, pg8::StaticOrder>(lds, g, S, E, TID());
                    } else if (ek == 3) {
                        pg8::Gemm g{(const bf16_t*)(ws + WS_H), LW + LW_IN / 2, 1024, 1024, 1024, 0, TSTEP1K, 0};
                        EpiProj E{(bf16_t*)(ws + WS_PA), (bf16_t*)(ws + WS_PG), SSQ + (size_t)(3 * l + 1) * T, SB + l * SB_LAYER + 5632};
                        pg8::gemm_phase<EpiProj, pg8::StaticOrder>(lds, g, S, E, TID());
                    } else {
                        const pg8::Gemm gj[3] = { pg8::Gemm{(const bf16_t*)(ws + WS_YAB), LW + LW_OA / 2, 1024, 512, 512, 0, TSTEP1K, 0},
                                                  pg8::Gemm{(const bf16_t*)(ws + WS_YAB) + 512, LW + LW_OB / 2, 1024, 512, 512, 0, TSTEP1K, 0},
                                                  pg8::Gemm{(const bf16_t*)(ws + WS_YC), LW + LW_PL / 2, 512, 128, 128, 128, (size_t)256 * 512 * 2, 0} };
                        EpiMix E{(bf16_t*)(ws + WS_MG), MGSv, (const bf16_t*)(ws + WS_PG), a->in[I_POOLS] + (size_t)l * D};
                        pg8::gemm_phase3<EpiMix, pg8::StaticOrder>(lds, gj, S, E, TID());
                    }
                    if (sig >= 0 && mine) dep_signal(DEP + 64 * sig, leader);
                }
            }
        }
#if ONE_LAUNCH
        if (PROBE_PRE && ph < 3 && ((PROBE_PRE >> ph) & 1)) { if (!redo) { redo = 1; --ph; } else redo = 0; }
        if (PROBE_MASK && ph >= 3 && ph < NPH - 1 && ((PROBE_MASK >> ((ph - 3) & 7)) & 1)) { if (!redo) { redo = 1; --ph; } else redo = 0; }
        if (ph + 1 < ph_hi) { XcdBarrier bar; bar.bar = (unsigned*)(ws + WS_CTL) + 4096; bar.x = xb_xcc_id(); bar.st = (volatile LAS unsigned*)(lds + MISC_OFF) + 8; xcd_barrier(bar); }
#endif
    }
}

extern "C" void kernel_launch(void* const* d_in, const int* in_sizes, int n_in, void* d_out, int out_size, void* d_ws, size_t ws_size, hipStream_t stream) {
    static int grid = 0;
    if (grid == 0) {
        if (n_in != 24 || (size_t)out_size != O_END || ws_size < WS_END) { fprintf(stderr, "kernel_launch: unexpected sizes n_in %d out %d ws %zu\n", n_in, out_size, ws_size); grid = -1; return; }
        int dev = 0, cus = 0;
        if (hipGetDevice(&dev) != hipSuccess || hipDeviceGetAttribute(&cus, hipDeviceAttributeMultiprocessorCount, dev) != hipSuccess) { grid = -1; return; }
        if (hipFuncSetAttribute((const void*)fwd, hipFuncAttributeMaxDynamicSharedMemorySize, LDS_BYTES) != hipSuccess) { fprintf(stderr, "kernel_launch: hipFuncSetAttribute failed\n"); grid = -1; return; }
        int per_cu = 0; (void)hipOccupancyMaxActiveBlocksPerMultiprocessor(&per_cu, (const void*)fwd, 512, LDS_BYTES); (void)hipGetLastError();
        grid = cus;
    }
    if (grid < 0) return;
    Args a{};
    for (int i = 0; i < 24; ++i) a.in[i] = (const float*)d_in[i];
    a.out = (float*)d_out; a.ws = (unsigned char*)d_ws;
#if ONE_LAUNCH
    (void)hipMemsetAsync((char*)d_ws + WS_CTL, 0, CTL_BYTES, stream);
    (void)hipMemsetAsync((char*)d_ws + WS_SSQ, 0, SSQ_BYTES, stream);
    a.ph_lo = 0; a.ph_hi = NPH;
    void* args[] = {&a};
    hipError_t e = hipLaunchCooperativeKernel((const void*)fwd, dim3(grid), dim3(512), args, LDS_BYTES, stream);
    if (e != hipSuccess) fprintf(stderr, "cooperative launch failed: %s (grid %d)\n", hipGetErrorString(e), grid);
#else
    for (int ph = 0; ph < NPH; ++ph) { a.ph_lo = ph; a.ph_hi = ph + 1; hipLaunchKernelGGL(fwd, dim3(grid), dim3(512), LDS_BYTES, stream, a); }
#endif
}
```

```cpp
#include <hip/hip_runtime.h>
#include <hip/hip_cooperative_groups.h>
#include <cstdio>
#include <cstdint>
namespace cg = cooperative_groups;

#define PROBE_PRE 0x0
#define PROBE_MASK 0x00
#ifndef ONE_LAUNCH
#define ONE_LAUNCH 1
#endif

#define GAS __attribute__((address_space(1)))
#define LAS __attribute__((address_space(3)))
typedef unsigned short bf16_t;
typedef short bf16x8 __attribute__((ext_vector_type(8)));
typedef float f32x4 __attribute__((ext_vector_type(4)));
typedef float f32x2 __attribute__((ext_vector_type(2)));
typedef unsigned u32x4 __attribute__((ext_vector_type(4)));
typedef unsigned u32x2 __attribute__((ext_vector_type(2)));

constexpr int D = 1024, TP = 16384, TS = 1024, T = TP + TS, NBATCH = 136, DEPTH = 4, DFF = 2816, NIN = 6144, NADA = 9216;
constexpr int NM = T / 256;
constexpr float EPS = 1e-6f;
constexpr size_t O_YP = 0, O_YS = 16777216, O_CP = 17825792, O_CS = 17858560, O_PP = 18382848, O_PS = 18628608, O_V = 22560768, O_END = 24657920;

constexpr size_t MiB = 1u << 20;
constexpr size_t WS_CTL = 0, CTL_BYTES = 1 * MiB;
constexpr size_t LW_GU1 = 0, LW_DN1 = LW_GU1 + (size_t)5632 * 1024 * 2, LW_GU2 = LW_DN1 + (size_t)1024 * 2816 * 2, LW_DN2 = LW_GU2 + (size_t)5632 * 1024 * 2,
                 LW_IN = LW_DN2 + (size_t)1024 * 2816 * 2, LW_OA = LW_IN + (size_t)6144 * 1024 * 2, LW_OB = LW_OA + (size_t)1024 * 512 * 2, LW_PL = LW_OB + (size_t)1024 * 512 * 2,
                 LW_WO = LW_PL + (size_t)1024 * 128 * 2, LW_TRIL = LW_WO + (size_t)1024 * 1024 * 2, LW_SAMP = LW_TRIL + (size_t)8 * 128 * 128 * 2, LW_SIZE = LW_SAMP + (size_t)8 * 128 * 128 * 2;
static_assert(LW_SIZE == 52166656, "layer weight block");
constexpr size_t WS_W = 1 * MiB;
constexpr size_t WS_ADAW = 200 * MiB;
constexpr size_t WS_SB = WS_ADAW;
constexpr size_t WS_YC = WS_ADAW + 40 * MiB;
constexpr size_t WS_CA = 272 * MiB;
constexpr size_t WS_X = 273 * MiB;
constexpr size_t WS_YAB = WS_X;
constexpr size_t WS_H = 341 * MiB;
constexpr size_t WS_MOD = 375 * MiB;
constexpr size_t WS_R = 395 * MiB;
constexpr size_t WS_PA = WS_R, WS_PG = WS_R + 102 * MiB, WS_G = WS_R, WS_MG = WS_R, WS_SH = WS_R + 150 * MiB;
constexpr size_t WS_SSQ = 616 * MiB;
constexpr size_t SSQ_BYTES = (size_t)13 * T * 4;
constexpr size_t WS_HISTP = 599 * MiB;
constexpr size_t WS_HISTC = 607 * MiB;
constexpr size_t WS_GS = 608 * MiB;
constexpr size_t WS_MGS = 614 * MiB;
constexpr size_t WS_END = 618 * MiB;
constexpr int SB_LD = 69632, SB_LAYER = 17408;
static_assert(WS_W + 4 * LW_SIZE <= WS_ADAW && WS_SB + (size_t)136 * SB_LD * 4 <= WS_YC && WS_YC + (size_t)T * 512 * 2 <= WS_CA && WS_X + (size_t)T * 1024 * 4 <= WS_H && WS_H + (size_t)T * 1024 * 2 <= WS_MOD &&
              WS_MOD + (size_t)136 * 36864 * 4 <= WS_R && WS_PG + (size_t)T * 3072 * 2 <= WS_HISTP && WS_GS + (size_t)TS * DFF * 2 <= WS_MGS && WS_MGS + (size_t)TS * D * 2 <= WS_SSQ && WS_SSQ + SSQ_BYTES <= WS_END, "ws map");

constexpr int LDS_BYTES = 147456, MISC_OFF = LDS_BYTES - 256;
constexpr int VT_PITCH = 136;

#define LDS_WAIT() asm volatile("s_waitcnt lgkmcnt(0)" ::: "memory")
#define VM_WAIT() asm volatile("s_waitcnt vmcnt(0)" ::: "memory")

__device__ __forceinline__ unsigned cvt_pk_bf16(float lo, float hi) { unsigned r; asm volatile("v_cvt_pk_bf16_f32 %0, %1, %2" : "=v"(r) : "v"(lo), "v"(hi)); return r; }
__device__ __forceinline__ float bf_lo(unsigned u) { return __uint_as_float(u << 16); }
__device__ __forceinline__ float bf_hi(unsigned u) { return __uint_as_float(u & 0xffff0000u); }
__device__ __forceinline__ void unpack8(const u32x4 r, float (&v)[8]) { v[0] = bf_lo(r.x); v[1] = bf_hi(r.x); v[2] = bf_lo(r.y); v[3] = bf_hi(r.y); v[4] = bf_lo(r.z); v[5] = bf_hi(r.z); v[6] = bf_lo(r.w); v[7] = bf_hi(r.w); }
__device__ __forceinline__ u32x4 pack8(const float (&v)[8]) { u32x4 r; r.x = cvt_pk_bf16(v[0], v[1]); r.y = cvt_pk_bf16(v[2], v[3]); r.z = cvt_pk_bf16(v[4], v[5]); r.w = cvt_pk_bf16(v[6], v[7]); return r; }
__device__ __forceinline__ float fast_sigmoid(float x) { return __builtin_amdgcn_rcpf(1.0f + __builtin_amdgcn_exp2f(-1.44269504089f * x)); }
__device__ __forceinline__ float fast_silu(float x) { return x * fast_sigmoid(x); }
template <class Tp> __device__ __forceinline__ Tp* sel_ptr(bool c, Tp* a, Tp* b) { const unsigned long long ua = (unsigned long long)a, ub = (unsigned long long)b; return (Tp*)(ub ^ ((ua ^ ub) & (0ull - (unsigned long long)c))); }
__device__ __forceinline__ int row_batch(int r) { return r < TP ? (r >> 11) : 8 + ((r - TP) >> 3); }
__device__ __forceinline__ float wave_sum(float v, int lane) {
#pragma unroll
    for (int o = 1; o < 64; o <<= 1) v += __int_as_float(__builtin_amdgcn_ds_bpermute((lane ^ o) << 2, __float_as_int(v)));
    return v;
}
__device__ __forceinline__ f32x2 gelu_pk(f32x2 v) {
    const f32x2 av = __builtin_elementwise_abs(v), d = av * 0.2316418882f + 1.0f;
    f32x2 t; t.x = __builtin_amdgcn_rcpf(d.x); t.y = __builtin_amdgcn_rcpf(d.y);
    f32x2 q = t * 0.5307027145f + (-0.7265760135f); q = q * t + 0.7107068705f; q = q * t + (-0.142248368f); q = q * t + 0.127414796f; q = q * t;
    const f32x2 s = (v * v) * (-0.72134752044f);
    f32x2 e; e.x = __builtin_amdgcn_exp2f(s.x); e.y = __builtin_amdgcn_exp2f(s.y);
    const f32x2 m = v * (q * e), r = v - m;
    f32x2 o; o.x = v.x < 0.f ? m.x : r.x; o.y = v.y < 0.f ? m.y : r.y; return o;
}

namespace pg8 {
constexpr int BM = 256, BK = 64, HALF = 128, HTB = HALF * BK * 2, STAGE_BYTES = 8 * HTB, NXCD = 8, WGM = 8;
__host__ __device__ __forceinline__ int lds_byte(int r, int c) { const int st = (r >> 4) * 2 + (c >> 5), rr = r & 15, cc = c & 31, ob = rr * 64 + cc * 2; return st * 1024 + (ob ^ (((ob >> 9) & 1) << 5)); }
__host__ __device__ __forceinline__ void stage_rc(int b, int& R, int& C) { const int st = b / 1024, sb = b % 1024, swz = sb ^ (((sb >> 9) & 1) << 5); R = (st >> 1) * 16 + swz / 64; C = (st & 1) * 32 + (swz % 64) / 2; }
__host__ __device__ __forceinline__ int perm32(int rho) { const int n = rho >> 4, i = rho & 15; return 8 * (i >> 2) + 4 * n + (i & 3); }

struct Unit { int pm, pn, job; };
struct Gemm { const bf16_t* A; const bf16_t* Bt; int lda, ldb, K, a_pn_off; size_t a_pm_stride, b_pm_stride; };

struct StaticOrder {
    int pm0, nM, nN, nwg, Gp, v, skc, skr, i0, rend, lofs;
    __device__ void init(int pm0_, int nM_, int nN_, int G, int c, int cu_off, int cu_cnt, int skc_, int skr_, int i0_ = 0, int rend_ = 1 << 20, int lofs_ = 0) { pm0 = pm0_; lofs = lofs_; nM = nM_; nN = nN_; nwg = nM * nN; Gp = cu_cnt; skc = skc_; skr = skr_; i0 = i0_; rend = rend_;
        int vv = c - cu_off; if (vv < 0) vv += G; v = vv < cu_cnt ? vv : -1; }
    __device__ void init(int nM_, int nN_, int G, int c) { init(0, nM_, nN_, G, c, 0, G, 0, 0); }
    __device__ bool next(int i, Unit& u) const {
        if (v < 0) return false;
        const int r0 = v < skc ? skr : 0, r = (r0 > i0 ? r0 : i0) + i;
        if (r >= rend) return false;
        const long L = lofs + (r < skr ? (long)r * (Gp - skc) + (v - skc) : (long)skr * (Gp - skc) + (long)(r - skr) * Gp + v);
        if (L >= nwg) return false;
        int wgid = (int)L; { const int q = nwg / NXCD, r = nwg % NXCD, xcd = wgid % NXCD, off = wgid / NXCD; wgid = (xcd < r ? xcd * (q + 1) : r * (q + 1) + (xcd - r) * q) + off; }
        const int nig = WGM * nN, gid = wgid / nig, fm = gid * WGM, gsz = (nM - fm) < WGM ? (nM - fm) : WGM;
        u.pm = pm0 + fm + ((wgid % nig) % gsz); u.pn = (wgid % nig) / gsz; return true;
    }
    __device__ __forceinline__ void a_ready(const Unit&) const {}
    __device__ __forceinline__ void done(const Unit&) const {}
};

template <class Epi, class Sched>
__device__ __forceinline__ void gemm_phase(LAS unsigned char* lds, const Gemm g, const Sched& S, const Epi& E, const int tid) {
    const int wid = __builtin_amdgcn_readfirstlane(tid >> 6), lane = tid & 63, wr = wid >> 2, wc = wid & 3, fr = lane & 15, fq = lane >> 4;
    const int nt = g.K / BK;
    unsigned voffA[2], voffB[2];
#pragma unroll
    for (int i = 0; i < 2; ++i) { int R, C; stage_rc(tid * 16 + i * 8192, R, C); const int Rb = Epi::PERM ? ((R & ~31) + perm32(R & 31)) : R;
        voffA[i] = (unsigned)(R * g.lda + C) * 2u; voffB[i] = (unsigned)(Rb * g.ldb + C) * 2u; }
    const size_t kstep = (size_t)(BK * 2);
    const size_t hstepA = (size_t)HALF * g.lda * 2, hstepB = (size_t)HALF * g.ldb * 2;
    const size_t tstepB = 2 * hstepB;
    const size_t pnoffA = (size_t)g.a_pn_off * 2;
    const unsigned ldsw = (unsigned)wid * 1024u;
    const int aoff = lds_byte(wr * 64 + fr, fq * 8), boff = lds_byte(wc * 32 + fr, fq * 8);
#define PG8_SA(b, h) (((b) * 2 + (h)) * HTB)
#define PG8_SB(b, h) ((4 + (b) * 2 + (h)) * HTB)
#define PG8_STAGE(bufoff, gbase, voff) do { _Pragma("unroll") for (int _i = 0; _i < 2; ++_i) \
        __builtin_amdgcn_global_load_lds((const GAS unsigned*)((const char*)(gbase) + (voff)[_i]), (LAS unsigned*)(lds + (bufoff) + ldsw + _i * 8192), 16, 0, 0); } while (0)
#define PG8_LDA(dst, b, h) do { _Pragma("unroll") for (int m = 0; m < 4; ++m) _Pragma("unroll") for (int k = 0; k < 2; ++k) dst[m][k] = *(const LAS bf16x8*)(lds + PG8_SA(b, h) + aoff + m * 2048 + k * 1024); } while (0)
#define PG8_LDB(dst, b, h) do { _Pragma("unroll") for (int n = 0; n < 2; ++n) _Pragma("unroll") for (int k = 0; k < 2; ++k) dst[n][k] = *(const LAS bf16x8*)(lds + PG8_SB(b, h) + boff + n * 2048 + k * 1024); } while (0)
#define PG8_MMA(ai, bj, At, Bt) do { __builtin_amdgcn_s_setprio(1); _Pragma("unroll") for (int m = 0; m < 4; ++m) _Pragma("unroll") for (int n = 0; n < 2; ++n) _Pragma("unroll") for (int k = 0; k < 2; ++k) \
        acc[ai][bj][m][n] = __builtin_amdgcn_mfma_f32_16x16x32_bf16(Bt[n][k], At[m][k], acc[ai][bj][m][n], 0, 0, 0); __builtin_amdgcn_s_setprio(0); } while (0)
#define PG8_WAIT_V(n) asm volatile("s_waitcnt vmcnt(" #n ")" ::: "memory")
#define PG8_WAIT_L(n) asm volatile("s_waitcnt lgkmcnt(" #n ")" ::: "memory")
#define PG8_BAR __builtin_amdgcn_s_barrier()
#define PG8_SCHED __builtin_amdgcn_sched_barrier(0)
    Unit cur, nxt; int ui = 0;
    if (!S.next(0, cur)) return;
    f32x4 acc[2][2][4][2];
#pragma unroll
    for (int a = 0; a < 2; ++a)
#pragma unroll
        for (int b = 0; b < 2; ++b)
#pragma unroll
            for (int m = 0; m < 4; ++m)
#pragma unroll
                for (int n = 0; n < 2; ++n) acc[a][b][m][n] = (f32x4){0.f, 0.f, 0.f, 0.f};
    bf16x8 At[4][2], B0[2][2], B1[2][2];
    typename Epi::Pre pre = {};
    const char* cA = (const char*)g.A + (size_t)cur.pm * g.a_pm_stride + (size_t)cur.pn * pnoffA; const char* cB = (const char*)g.Bt + (size_t)cur.pn * tstepB + (size_t)cur.pm * g.b_pm_stride;
    S.a_ready(cur);
    PG8_STAGE(PG8_SB(0, 0), cB, voffB); PG8_STAGE(PG8_SB(0, 1), cB + hstepB, voffB); PG8_STAGE(PG8_SA(0, 0), cA, voffA); PG8_STAGE(PG8_SA(0, 1), cA + hstepA, voffA);
    if (wr == 1) PG8_BAR;
    PG8_WAIT_V(2); PG8_BAR;
    PG8_STAGE(PG8_SB(1, 0), cB + kstep, voffB); PG8_STAGE(PG8_SA(1, 0), cA + kstep, voffA); PG8_STAGE(PG8_SB(1, 1), cB + hstepB + kstep, voffB);
    PG8_WAIT_V(6); PG8_BAR;
    for (;;) {
        const bool has_next = S.next(ui + 1, nxt);
        const char* nA = has_next ? (const char*)g.A + (size_t)nxt.pm * g.a_pm_stride + (size_t)nxt.pn * pnoffA : cA; const char* nB = has_next ? (const char*)g.Bt + (size_t)nxt.pn * tstepB + (size_t)nxt.pm * g.b_pm_stride : cB;
        for (int t = 0; t < nt; t += 2) {
            const bool last = (t == nt - 2);
            const char* a1 = cA + (size_t)(t + 1) * kstep;
            const char* a2 = last ? nA : cA + (size_t)(t + 2) * kstep; const char* b2 = last ? nB : cB + (size_t)(t + 2) * kstep;
            const char* a3 = a2 + kstep; const char* b3 = b2 + kstep;
            if (last && has_next) S.a_ready(nxt);
            if (last) { pre = E.pre(cur, wr, wc, fr, fq); PG8_SCHED; }
            PG8_LDB(B0, 0, 0); PG8_LDB(B1, 0, 1); PG8_SCHED; PG8_LDA(At, 0, 0); PG8_STAGE(PG8_SA(1, 1), a1 + hstepA, voffA);
            PG8_WAIT_V(8); PG8_WAIT_L(0); PG8_BAR; PG8_MMA(0, 0, At, B0); PG8_MMA(0, 1, At, B1); PG8_BAR; PG8_SCHED;
            PG8_LDA(At, 0, 1); PG8_STAGE(PG8_SB(0, 0), b2, voffB); PG8_STAGE(PG8_SB(0, 1), b2 + hstepB, voffB); PG8_STAGE(PG8_SA(0, 0), a2, voffA);
            PG8_WAIT_V(8); PG8_WAIT_L(0); PG8_BAR; PG8_MMA(1, 0, At, B0); PG8_MMA(1, 1, At, B1); PG8_BAR; PG8_SCHED;
            PG8_LDB(B0, 1, 0); PG8_LDB(B1, 1, 1); PG8_SCHED; PG8_LDA(At, 1, 0); PG8_STAGE(PG8_SA(0, 1), a2 + hstepA, voffA);
            PG8_WAIT_V(8); PG8_WAIT_L(0); PG8_BAR; PG8_MMA(0, 0, At, B0); PG8_MMA(0, 1, At, B1); PG8_BAR; PG8_SCHED;
            PG8_LDA(At, 1, 1); PG8_STAGE(PG8_SB(1, 0), b3, voffB); PG8_STAGE(PG8_SB(1, 1), b3 + hstepB, voffB); PG8_STAGE(PG8_SA(1, 0), a3, voffA);
            PG8_WAIT_V(8); PG8_WAIT_L(0); PG8_BAR; PG8_MMA(1, 0, At, B0); PG8_MMA(1, 1, At, B1); PG8_BAR; PG8_SCHED;
        }
        if (wr == 0) PG8_BAR;
        { Unit eu; eu.pm = __builtin_amdgcn_readfirstlane(cur.pm); eu.pn = __builtin_amdgcn_readfirstlane(cur.pn); eu.job = 0; asm volatile("" : "+s"(eu.pm), "+s"(eu.pn));
          int efr = fr; asm volatile("" : "+v"(efr));
          E(acc, eu, wr, wc, efr, fq, pre); }
        S.done(cur);
        if (!has_next) break;
#pragma unroll
        for (int a = 0; a < 2; ++a)
#pragma unroll
            for (int b = 0; b < 2; ++b)
#pragma unroll
                for (int m = 0; m < 4; ++m)
#pragma unroll
                    for (int n = 0; n < 2; ++n) acc[a][b][m][n] = (f32x4){0.f, 0.f, 0.f, 0.f};
        cur = nxt; cA = nA; cB = nB; ++ui;
        if (wr == 1) PG8_BAR;
    }
    PG8_WAIT_V(0);
    PG8_BAR;
#undef PG8_SA
#undef PG8_SB
#undef PG8_STAGE
#undef PG8_LDA
#undef PG8_LDB
#undef PG8_MMA
#undef PG8_WAIT_V
#undef PG8_WAIT_L
#undef PG8_BAR
#undef PG8_SCHED
}
template <class Epi, class Sched>
__device__ __forceinline__ void gemm_phase3(LAS unsigned char* lds, const Gemm (&gj)[3], const Sched& S, const Epi& E, const int tid) {
    const int wid = __builtin_amdgcn_readfirstlane(tid >> 6), lane = tid & 63, wr = wid >> 2, wc = wid & 3, fr = lane & 15, fq = lane >> 4;
    int sR[2], sRb[2], sC[2];
#pragma unroll
    for (int i = 0; i < 2; ++i) { stage_rc(tid * 16 + i * 8192, sR[i], sC[i]); sRb[i] = Epi::PERM ? ((sR[i] & ~31) + perm32(sR[i] & 31)) : sR[i]; }
    const size_t kstep = (size_t)(BK * 2);
    int nt; unsigned voffA[2], voffB[2], nvoffA[2], nvoffB[2]; size_t hstepA, hstepB, nhstepA, nhstepB;
#define PG8_JOBPARAMS(J, VA, VB, HA, HB) do { _Pragma("unroll") for (int _i = 0; _i < 2; ++_i) { VA[_i] = (unsigned)(sR[_i] * gj[J].lda + sC[_i]) * 2u; VB[_i] = (unsigned)(sRb[_i] * gj[J].ldb + sC[_i]) * 2u; } \
        HA = (size_t)HALF * gj[J].lda * 2; HB = (size_t)HALF * gj[J].ldb * 2; } while (0)
#define PG8_ABASE(J, U) ((const char*)gj[J].A + (size_t)(U).pm * gj[J].a_pm_stride + (size_t)(U).pn * ((size_t)gj[J].a_pn_off * 2))
#define PG8_BBASE(J, U) ((const char*)gj[J].Bt + (size_t)(U).pn * ((size_t)BM * gj[J].ldb * 2) + (size_t)(U).pm * gj[J].b_pm_stride)
    const unsigned ldsw = (unsigned)wid * 1024u;
    const int aoff = lds_byte(wr * 64 + fr, fq * 8), boff = lds_byte(wc * 32 + fr, fq * 8);
#define PG8_SA(b, h) (((b) * 2 + (h)) * HTB)
#define PG8_SB(b, h) ((4 + (b) * 2 + (h)) * HTB)
#define PG8_STAGE(bufoff, gbase, voff) do { _Pragma("unroll") for (int _i = 0; _i < 2; ++_i) \
        __builtin_amdgcn_global_load_lds((const GAS unsigned*)((const char*)(gbase) + (voff)[_i]), (LAS unsigned*)(lds + (bufoff) + ldsw + _i * 8192), 16, 0, 0); } while (0)
#define PG8_LDA(dst, b, h) do { _Pragma("unroll") for (int m = 0; m < 4; ++m) _Pragma("unroll") for (int k = 0; k < 2; ++k) dst[m][k] = *(const LAS bf16x8*)(lds + PG8_SA(b, h) + aoff + m * 2048 + k * 1024); } while (0)
#define PG8_LDB(dst, b, h) do { _Pragma("unroll") for (int n = 0; n < 2; ++n) _Pragma("unroll") for (int k = 0; k < 2; ++k) dst[n][k] = *(const LAS bf16x8*)(lds + PG8_SB(b, h) + boff + n * 2048 + k * 1024); } while (0)
#define PG8_MMA(ai, bj, At, Bt) do { __builtin_amdgcn_s_setprio(1); _Pragma("unroll") for (int m = 0; m < 4; ++m) _Pragma("unroll") for (int n = 0; n < 2; ++n) _Pragma("unroll") for (int k = 0; k < 2; ++k) \
        acc[ai][bj][m][n] = __builtin_amdgcn_mfma_f32_16x16x32_bf16(Bt[n][k], At[m][k], acc[ai][bj][m][n], 0, 0, 0); __builtin_amdgcn_s_setprio(0); } while (0)
#define PG8_WAIT_V(n) asm volatile("s_waitcnt vmcnt(" #n ")" ::: "memory")
#define PG8_WAIT_L(n) asm volatile("s_waitcnt lgkmcnt(" #n ")" ::: "memory")
#define PG8_BAR __builtin_amdgcn_s_barrier()
#define PG8_SCHED __builtin_amdgcn_sched_barrier(0)
    Unit cur, nxt; int ui = 0;
    if (!S.next(0, cur)) return;
    cur.job = 0; PG8_JOBPARAMS(0, voffA, voffB, hstepA, hstepB); nt = gj[0].K / BK;
    f32x4 acc[2][2][4][2];
#pragma unroll
    for (int a = 0; a < 2; ++a)
#pragma unroll
        for (int b = 0; b < 2; ++b)
#pragma unroll
            for (int m = 0; m < 4; ++m)
#pragma unroll
                for (int n = 0; n < 2; ++n) acc[a][b][m][n] = (f32x4){0.f, 0.f, 0.f, 0.f};
    bf16x8 At[4][2], B0[2][2], B1[2][2];
    typename Epi::Pre pre = {};
    const char* cA = PG8_ABASE(0, cur); const char* cB = PG8_BBASE(0, cur);
    S.a_ready(cur);
    PG8_STAGE(PG8_SB(0, 0), cB, voffB); PG8_STAGE(PG8_SB(0, 1), cB + hstepB, voffB); PG8_STAGE(PG8_SA(0, 0), cA, voffA); PG8_STAGE(PG8_SA(0, 1), cA + hstepA, voffA);
    if (wr == 1) PG8_BAR;
    PG8_WAIT_V(2); PG8_BAR;
    PG8_STAGE(PG8_SB(1, 0), cB + kstep, voffB); PG8_STAGE(PG8_SA(1, 0), cA + kstep, voffA); PG8_STAGE(PG8_SB(1, 1), cB + hstepB + kstep, voffB);
    PG8_WAIT_V(6); PG8_BAR;
    for (;;) {
        const int nj = (ui + 1) % 3;
        const bool has_next = S.next((ui + 1) / 3, nxt); nxt.job = nj;
        const char* nA = cA; const char* nB = cB;
#pragma unroll
        for (int _i = 0; _i < 2; ++_i) { nvoffA[_i] = voffA[_i]; nvoffB[_i] = voffB[_i]; } nhstepA = hstepA; nhstepB = hstepB;
        if (has_next) { if (nj == 0) { PG8_JOBPARAMS(0, nvoffA, nvoffB, nhstepA, nhstepB); nA = PG8_ABASE(0, nxt); nB = PG8_BBASE(0, nxt); }
                        else if (nj == 1) { PG8_JOBPARAMS(1, nvoffA, nvoffB, nhstepA, nhstepB); nA = PG8_ABASE(1, nxt); nB = PG8_BBASE(1, nxt); }
                        else { PG8_JOBPARAMS(2, nvoffA, nvoffB, nhstepA, nhstepB); nA = PG8_ABASE(2, nxt); nB = PG8_BBASE(2, nxt); } }
        for (int t = 0; t < nt; t += 2) {
            const bool last = (t == nt - 2);
            const char* a1 = cA + (size_t)(t + 1) * kstep;
            const char* a2 = last ? nA : cA + (size_t)(t + 2) * kstep; const char* b2 = last ? nB : cB + (size_t)(t + 2) * kstep;
            const char* a3 = a2 + kstep; const char* b3 = b2 + kstep;
            unsigned vA2[2], vB2[2]; vA2[0] = last ? nvoffA[0] : voffA[0]; vA2[1] = last ? nvoffA[1] : voffA[1]; vB2[0] = last ? nvoffB[0] : voffB[0]; vB2[1] = last ? nvoffB[1] : voffB[1];
            const size_t hA2 = last ? nhstepA : hstepA, hB2 = last ? nhstepB : hstepB;
            if (last && has_next) S.a_ready(nxt);
            if (last) { pre = E.pre(cur, wr, wc, fr, fq); PG8_SCHED; }
            PG8_LDB(B0, 0, 0); PG8_LDB(B1, 0, 1); PG8_SCHED; PG8_LDA(At, 0, 0); PG8_STAGE(PG8_SA(1, 1), a1 + hstepA, voffA);
            PG8_WAIT_V(8); PG8_WAIT_L(0); PG8_BAR; PG8_MMA(0, 0, At, B0); PG8_MMA(0, 1, At, B1); PG8_BAR; PG8_SCHED;
            PG8_LDA(At, 0, 1); PG8_STAGE(PG8_SB(0, 0), b2, vB2); PG8_STAGE(PG8_SB(0, 1), b2 + hB2, vB2); PG8_STAGE(PG8_SA(0, 0), a2, vA2);
            PG8_WAIT_V(8); PG8_WAIT_L(0); PG8_BAR; PG8_MMA(1, 0, At, B0); PG8_MMA(1, 1, At, B1); PG8_BAR; PG8_SCHED;
            PG8_LDB(B0, 1, 0); PG8_LDB(B1, 1, 1); PG8_SCHED; PG8_LDA(At, 1, 0); PG8_STAGE(PG8_SA(0, 1), a2 + hA2, vA2);
            PG8_WAIT_V(8); PG8_WAIT_L(0); PG8_BAR; PG8_MMA(0, 0, At, B0); PG8_MMA(0, 1, At, B1); PG8_BAR; PG8_SCHED;
            PG8_LDA(At, 1, 1); PG8_STAGE(PG8_SB(1, 0), b3, vB2); PG8_STAGE(PG8_SB(1, 1), b3 + hB2, vB2); PG8_STAGE(PG8_SA(1, 0), a3, vA2);
            PG8_WAIT_V(8); PG8_WAIT_L(0); PG8_BAR; PG8_MMA(1, 0, At, B0); PG8_MMA(1, 1, At, B1); PG8_BAR; PG8_SCHED;
        }
        if (wr == 0) PG8_BAR;
        { Unit eu; eu.pm = __builtin_amdgcn_readfirstlane(cur.pm); eu.pn = __builtin_amdgcn_readfirstlane(cur.pn); eu.job = __builtin_amdgcn_readfirstlane(cur.job); asm volatile("" : "+s"(eu.pm), "+s"(eu.pn));
          int efr = fr; asm volatile("" : "+v"(efr));
          E(acc, eu, wr, wc, efr, fq, pre); }
        S.done(cur);
        if (!has_next) break;
        if (nxt.job == 0)
#pragma unroll
        for (int a = 0; a < 2; ++a)
#pragma unroll
            for (int b = 0; b < 2; ++b)
#pragma unroll
                for (int m = 0; m < 4; ++m)
#pragma unroll
                    for (int n = 0; n < 2; ++n) acc[a][b][m][n] = (f32x4){0.f, 0.f, 0.f, 0.f};
        cur = nxt; cA = nA; cB = nB; ++ui;
#pragma unroll
        for (int _i = 0; _i < 2; ++_i) { voffA[_i] = nvoffA[_i]; voffB[_i] = nvoffB[_i]; } hstepA = nhstepA; hstepB = nhstepB; nt = gj[0].K / BK; if (cur.job == 1) nt = gj[1].K / BK; if (cur.job == 2) nt = gj[2].K / BK;
        if (wr == 1) PG8_BAR;
    }
    PG8_WAIT_V(0);
    PG8_BAR;
#undef PG8_JOBPARAMS
#undef PG8_ABASE
#undef PG8_BBASE
#undef PG8_SA
#undef PG8_SB
#undef PG8_STAGE
#undef PG8_LDA
#undef PG8_LDB
#undef PG8_MMA
#undef PG8_WAIT_V
#undef PG8_WAIT_L
#undef PG8_BAR
#undef PG8_SCHED
}
}

typedef unsigned ssq_t;
constexpr float SSQ_SCALE = 4096.0f, SSQ_INV = 1.0f / 4096.0f;
__device__ __forceinline__ float row_rstd(const ssq_t* ssq, int r) { return __builtin_amdgcn_rsqf((float)*(const GAS ssq_t*)(ssq + r) * (SSQ_INV / D) + EPS); }
struct EpiAda {
    static constexpr bool PERM = false;
    float* mod; const float* bias; const float* normg; bf16_t* sh;
    struct Pre {}; __device__ __forceinline__ Pre pre(const pg8::Unit&, int, int, int, int) const { return Pre{}; }
    __device__ __forceinline__ void operator()(const f32x4 (&acc)[2][2][4][2], const pg8::Unit& u, int wr, int wc, int fr, int fq, const Pre&) const {
        const int row0 = wr * 64 + fr, col0 = u.pn * 256 + wc * 32 + 4 * fq;
        const int l = (u.pn * 256) / NADA, rem = u.pn * 256 - l * NADA, sub3 = rem >> 10, which = sub3 % 3, sub = sub3 / 3, d0 = (rem & 1023) + wc * 32 + 4 * fq;
#pragma unroll
        for (int ai = 0; ai < 2; ++ai)
#pragma unroll
            for (int m = 0; m < 4; ++m) { const int r = row0 + ai * 128 + m * 16;
                if (r < NBATCH) {
#pragma unroll
                    for (int bj = 0; bj < 2; ++bj)
#pragma unroll
                        for (int n = 0; n < 2; ++n) { const int o = bj * 128 + n * 16; f32x4 v = acc[ai][bj][m][n] + *(const GAS f32x4*)(bias + col0 + o);
                            if (which == 0) { u32x2 w; w.x = cvt_pk_bf16(v[0], v[1]); w.y = cvt_pk_bf16(v[2], v[3]); *(GAS u32x2*)(sh + ((size_t)(l * 3 + sub) * 256 + r) * D + d0 + o) = w; }
                            else { if (which == 1) v = *(const GAS f32x4*)(normg + (l * 3 + sub) * D + d0 + o) * (v + 1.0f);
                                *(GAS f32x4*)(mod + (size_t)r * 36864 + col0 + o) = v; } } } }
    }
};
struct EpiSB {
    static constexpr bool PERM = false;
    float* sb; int off;
    struct Pre {}; __device__ __forceinline__ Pre pre(const pg8::Unit&, int, int, int, int) const { return Pre{}; }
    __device__ __forceinline__ void operator()(const f32x4 (&acc)[2][2][4][2], const pg8::Unit& u, int wr, int wc, int fr, int fq, const Pre&) const {
        const int row0 = wr * 64 + fr, col0 = u.pm * SB_LAYER + off + u.pn * 256 + wc * 32 + 4 * fq;
#pragma unroll
        for (int ai = 0; ai < 2; ++ai)
#pragma unroll
            for (int m = 0; m < 4; ++m) { const int r = row0 + ai * 128 + m * 16;
                if (r < NBATCH) {
#pragma unroll
                    for (int bj = 0; bj < 2; ++bj)
#pragma unroll
                        for (int n = 0; n < 2; ++n) *(GAS f32x4*)(sb + (size_t)r * SB_LD + col0 + bj * 128 + n * 16) = acc[ai][bj][m][n]; } }
    }
};
struct EpiSwiglu {
    static constexpr bool PERM = true;
    bf16_t* G; bf16_t* GSv; const ssq_t* ssq; const float* sb;
    struct Pre { ssq_t rs[8]; f32x4 sa[2], sbb[2]; };
    __device__ __forceinline__ Pre pre(const pg8::Unit& u, int wr, int wc, int fr, int fq) const {
        Pre p; const int row0 = u.pm * 256 + wr * 64 + fr, scol = u.pn * 256 + wc * 32 + 8 * fq;
#pragma unroll
        for (int i = 0; i < 8; ++i) p.rs[i] = *(const GAS ssq_t*)(ssq + row0 + (i >> 2) * 128 + (i & 3) * 16);
        const float* sp = sb + (size_t)(u.pm < 64 ? (u.pm >> 3) : 0) * SB_LD + scol;
#pragma unroll
        for (int n = 0; n < 2; ++n) { p.sa[n] = *(const GAS f32x4*)(sp + 4 * n); p.sbb[n] = *(const GAS f32x4*)(sp + 128 + 4 * n); }
        return p;
    }
    __device__ __forceinline__ void operator()(const f32x4 (&acc)[2][2][4][2], const pg8::Unit& u, int wr, int wc, int fr, int fq, const Pre& p) const {
        const int row0 = u.pm * 256 + wr * 64 + fr, col0 = u.pn * 128 + wc * 32 + 8 * fq, scol = u.pn * 256 + wc * 32 + 8 * fq;
        const bool uni = u.pm < 64;
        bf16_t* Gb = sel_ptr(uni, G, GSv);
        float rs[8];
#pragma unroll
        for (int i = 0; i < 8; ++i) rs[i] = (float)p.rs[i] * SSQ_INV;
        f32x4 sa[2], sbb[2];
#pragma unroll
        for (int n = 0; n < 2; ++n) { sa[n] = p.sa[n]; sbb[n] = p.sbb[n]; }
#pragma unroll
        for (int i = 0; i < 8; ++i) { const int ai = i >> 2, m = i & 3, r = row0 + ai * 128 + m * 16; const float rr = __builtin_amdgcn_rsqf(rs[i] * (1.f / D) + EPS); float v[8];
            if (!uni) { const float* sp = sb + (size_t)row_batch(r) * SB_LD + scol;
#pragma unroll
                for (int n = 0; n < 2; ++n) { sa[n] = *(const GAS f32x4*)(sp + 4 * n); sbb[n] = *(const GAS f32x4*)(sp + 128 + 4 * n); } }
#pragma unroll
            for (int n = 0; n < 2; ++n)
#pragma unroll
                for (int j = 0; j < 4; ++j) v[n * 4 + j] = fast_silu(acc[ai][0][m][n][j] * rr + sa[n][j]) * (acc[ai][1][m][n][j] * rr + sbb[n][j]);
            *(GAS u32x4*)(Gb + (size_t)r * DFF + col0) = pack8(v); }
    }
};
struct EpiResid {
    static constexpr bool PERM = true;
    const float* gate0; const float* gsc0; const float* gsn0; bf16_t* H; ssq_t* ssq; float s; int fin;
    struct Pre {}; __device__ __forceinline__ Pre pre(const pg8::Unit&, int, int, int, int) const { return Pre{}; }
    __device__ __forceinline__ void operator()(const f32x4 (&acc)[2][2][4][2], const pg8::Unit& u, int wr, int wc, int fr, int fq, const Pre&) const {
        const int row0 = u.pm * 256 + wr * 64 + fr, col0 = u.pn * 256 + wc * 32 + 8 * fq, ln = fr + 16 * fq;
        const bool uni = u.pm < 64;
        f32x4 g[2][2], hs[2][2], rc[2][2];
#define ER_LOAD(bo) do { _Pragma("unroll") for (int bj = 0; bj < 2; ++bj) _Pragma("unroll") for (int n = 0; n < 2; ++n) { const size_t o = (bo) + bj * 128 + n * 4; g[bj][n] = *(const GAS f32x4*)(gate0 + o) * s; \
            const f32x4 c = *(const GAS f32x4*)(gsc0 + o); rc[bj][n] = (f32x4){__builtin_amdgcn_rcpf(c[0]), __builtin_amdgcn_rcpf(c[1]), __builtin_amdgcn_rcpf(c[2]), __builtin_amdgcn_rcpf(c[3])}; \
            hs[bj][n] = fin ? (f32x4){1.f, 1.f, 1.f, 1.f} : *(const GAS f32x4*)(gsn0 + o); } } while (0)
        if (uni) ER_LOAD((size_t)(u.pm >> 3) * 36864 + col0);
#pragma unroll
        for (int am = 0; am < 4; ++am) { const int ai = am >> 1, m0 = (am & 1) * 2;
            u32x4 xr[4][2];
#pragma unroll
            for (int m = m0; m < m0 + 2; ++m)
#pragma unroll
                for (int bj = 0; bj < 2; ++bj) xr[m][bj] = *(const GAS u32x4*)(H + (size_t)(row0 + ai * 128 + m * 16) * D + col0 + bj * 128);
#pragma unroll
            for (int m = m0; m < m0 + 2; ++m) { const int r = row0 + ai * 128 + m * 16; float q = 0.f;
                if (!uni) ER_LOAD((size_t)row_batch(r) * 36864 + col0);
#pragma unroll
                for (int bj = 0; bj < 2; ++bj) { float x[8]; unpack8(xr[m][bj], x);
#pragma unroll
                    for (int n = 0; n < 2; ++n)
#pragma unroll
                        for (int j = 0; j < 4; ++j) { const float v = x[n * 4 + j] * rc[bj][n][j] + g[bj][n][j] * acc[ai][bj][m][n][j]; q += v * v; x[n * 4 + j] = v * hs[bj][n][j]; }
                    *(GAS u32x4*)(H + (size_t)r * D + col0 + bj * 128) = pack8(x); }
                q += __int_as_float(__builtin_amdgcn_ds_bpermute((ln ^ 16) << 2, __float_as_int(q))); q += __int_as_float(__builtin_amdgcn_ds_bpermute((ln ^ 32) << 2, __float_as_int(q)));
                if (fq == 0) (void)__hip_atomic_fetch_add(ssq + r, (ssq_t)(q * SSQ_SCALE + 0.5f), __ATOMIC_RELAXED, __HIP_MEMORY_SCOPE_AGENT); } }
#undef ER_LOAD
    }
};
struct EpiProj {
    static constexpr bool PERM = true;
    bf16_t* PA; bf16_t* PG; const ssq_t* ssq; const float* sb;
    struct Pre { ssq_t rs[8]; f32x4 sv[2][2]; };
    __device__ __forceinline__ Pre pre(const pg8::Unit& u, int wr, int wc, int fr, int fq) const {
        Pre p; const int row0 = u.pm * 256 + wr * 64 + fr, scol = u.pn * 256 + wc * 32 + 8 * fq;
#pragma unroll
        for (int i = 0; i < 8; ++i) p.rs[i] = *(const GAS ssq_t*)(ssq + row0 + (i >> 2) * 128 + (i & 3) * 16);
        const float* sp = sb + (size_t)(u.pm < 64 ? (u.pm >> 3) : 0) * SB_LD + scol;
#pragma unroll
        for (int bj = 0; bj < 2; ++bj)
#pragma unroll
            for (int n = 0; n < 2; ++n) p.sv[bj][n] = *(const GAS f32x4*)(sp + bj * 128 + 4 * n);
        return p;
    }
    __device__ __forceinline__ void operator()(const f32x4 (&acc)[2][2][4][2], const pg8::Unit& u, int wr, int wc, int fr, int fq, const Pre& p) const {
        const int row0 = u.pm * 256 + wr * 64 + fr, scol = u.pn * 256 + wc * 32 + 8 * fq;
        const int act = (u.pn >= 12) ? 2 : ((u.pn >= 6 && u.pn < 10) ? 1 : 0);
        bf16_t* P = u.pn >= 12 ? PG + (u.pn - 12) * 256 + wc * 32 + 8 * fq : PA + scol;
        const bool uni = u.pm < 64;
        float rs[8];
#pragma unroll
        for (int i = 0; i < 8; ++i) rs[i] = (float)p.rs[i] * SSQ_INV;
        f32x4 sv[2][2];
#pragma unroll
        for (int bj = 0; bj < 2; ++bj)
#pragma unroll
            for (int n = 0; n < 2; ++n) sv[bj][n] = p.sv[bj][n];
#pragma unroll
        for (int i = 0; i < 8; ++i) { const int ai = i >> 2, m = i & 3, r = row0 + ai * 128 + m * 16; const float rr = __builtin_amdgcn_rsqf(rs[i] * (1.f / D) + EPS); bf16_t* rowp = P + (size_t)r * 3072;
            if (!uni) { const float* sp = sb + (size_t)row_batch(r) * SB_LD + scol;
#pragma unroll
                for (int bj = 0; bj < 2; ++bj)
#pragma unroll
                    for (int n = 0; n < 2; ++n) sv[bj][n] = *(const GAS f32x4*)(sp + bj * 128 + 4 * n); }
#pragma unroll
            for (int bj = 0; bj < 2; ++bj) { float v[8];
#pragma unroll
                for (int n = 0; n < 2; ++n)
#pragma unroll
                    for (int j = 0; j < 4; ++j) v[n * 4 + j] = acc[ai][bj][m][n][j] * rr + sv[bj][n][j];
                if (act == 1) {
#pragma unroll
                    for (int q = 0; q < 4; ++q) { const f32x2 o = gelu_pk((f32x2){v[2 * q], v[2 * q + 1]}); v[2 * q] = o.x; v[2 * q + 1] = o.y; } }
                else if (act == 2) {
#pragma unroll
                    for (int q = 0; q < 8; ++q) v[q] = fast_sigmoid(v[q]); }
                *(GAS u32x4*)(rowp + bj * 128) = pack8(v); } }
    }
};
struct EpiMix {
    static constexpr bool PERM = true;
    bf16_t* MgP; bf16_t* MgSv; const bf16_t* sg0; const float* ps0;
    struct Pre {}; __device__ __forceinline__ Pre pre(const pg8::Unit&, int, int, int, int) const { return Pre{}; }
    __device__ __forceinline__ void operator()(f32x4 (&acc)[2][2][4][2], const pg8::Unit& u, int wr, int wc, int fr, int fq, const Pre&) const {
        const int row0 = u.pm * 256 + wr * 64 + fr, col0 = u.pn * 256 + wc * 32 + 8 * fq, job = u.job;
        bf16_t* Mg = sel_ptr(u.pm < 64, MgP, MgSv);
        const bf16_t* gN = sg0 + (job == 0 ? 0 : (job == 1 ? 1024 : 2048));
        const bf16_t* gD = sg0 + (job == 0 ? 1024 : 2048);
        float sc[2][8];
#pragma unroll
        for (int bj = 0; bj < 2; ++bj) { const int c = col0 + bj * 128; const f32x4 p0 = *(const GAS f32x4*)(ps0 + c), p1 = *(const GAS f32x4*)(ps0 + c + 4);
            sc[bj][0] = p0[0]; sc[bj][1] = p0[1]; sc[bj][2] = p0[2]; sc[bj][3] = p0[3]; sc[bj][4] = p1[0]; sc[bj][5] = p1[1]; sc[bj][6] = p1[2]; sc[bj][7] = p1[3]; }
#pragma unroll
        for (int am = 0; am < 4; ++am) { const int ai = am >> 1, m0 = (am & 1) * 2;
            u32x4 nr[4][2], dr[4][2];
#pragma unroll
            for (int m = m0; m < m0 + 2; ++m)
#pragma unroll
                for (int bj = 0; bj < 2; ++bj) { const size_t r = (size_t)(row0 + ai * 128 + m * 16); nr[m][bj] = *(const GAS u32x4*)(gN + r * 3072 + col0 + bj * 128);
                    dr[m][bj] = job < 2 ? *(const GAS u32x4*)(gD + r * 3072 + col0 + bj * 128) : (u32x4){0u, 0u, 0u, 0u}; }
#pragma unroll
            for (int m = m0; m < m0 + 2; ++m) { const size_t r = (size_t)(row0 + ai * 128 + m * 16);
#pragma unroll
                for (int bj = 0; bj < 2; ++bj) { float n8[8], d8[8]; unpack8(nr[m][bj], n8); unpack8(dr[m][bj], d8);
                    if (job == 2) { float v[8];
#pragma unroll
                        for (int n = 0; n < 2; ++n)
#pragma unroll
                            for (int j = 0; j < 4; ++j) v[n * 4 + j] = acc[ai][bj][m][n][j] * n8[n * 4 + j] * sc[bj][n * 4 + j];
                        *(GAS u32x4*)(Mg + r * D + col0 + bj * 128) = pack8(v); }
                    else {
#pragma unroll
                        for (int n = 0; n < 2; ++n)
#pragma unroll
                            for (int j = 0; j < 4; ++j) { const float den = fmaxf(job == 0 ? d8[n * 4 + j] : d8[n * 4 + j] * sc[bj][n * 4 + j] * (sc[bj][n * 4 + j] < 0.f ? -1.f : 1.f), 1e-30f) * (job == 1 && sc[bj][n * 4 + j] < 0.f ? -1.f : 1.f);
                                acc[ai][bj][m][n][j] *= n8[n * 4 + j] * __builtin_amdgcn_rcpf(den); } } } } }
    }
};

#define XB_TMO      128
#define XB_XCNT(j)  (256  + 64 * (j))
#define XB_XSUB(j)  (1280 + 64 * (j))
#define XB_XGEN(j)  (2304 + 64 * (j))
#define XB_TOP      3328
#define XB_TOPGEN   3392
#define XCD_BAR_WORDS 3456
#define XB_SPIN_CAP (1u << 22)
__device__ __forceinline__ unsigned xb_ld(unsigned* p)              { return __hip_atomic_load(p, __ATOMIC_RELAXED, __HIP_MEMORY_SCOPE_AGENT); }
__device__ __forceinline__ unsigned xb_add(unsigned* p, unsigned v) { return __hip_atomic_fetch_add(p, v, __ATOMIC_RELAXED, __HIP_MEMORY_SCOPE_AGENT); }
__device__ __forceinline__ unsigned xb_xcc_id() { return (unsigned)__builtin_amdgcn_s_getreg((3 << 11) | 20) & 0xFu; }
#define XB_SPIN(cond, bar) do { unsigned _sp = 0; while (cond) { __builtin_amdgcn_s_sleep(1); \
    if ((++_sp & 255u) == 0u) { if (xb_ld(&(bar)[XB_TMO])) break; if (_sp > XB_SPIN_CAP) { atomicAdd(&(bar)[XB_TMO], 1u); break; } } } } while (0)
struct XcdBarrier { unsigned* bar; unsigned x; volatile LAS unsigned* st; };
__device__ __forceinline__ XcdBarrier xcd_barrier_post(unsigned* bar, volatile LAS unsigned* st) {
    XcdBarrier b; b.bar = bar; b.x = xb_xcc_id(); b.st = st;
    if (threadIdx.x == 0) (void)xb_add(&bar[XB_XCNT(b.x)], 1u);
    return b;
}
__device__ __forceinline__ void xcd_barrier_complete(unsigned* bar, unsigned x, unsigned& nloc, unsigned& nx) {
    const unsigned G = gridDim.x * gridDim.y * gridDim.z;
    unsigned sum, cnt, mine, sp = 0u;
    for (;;) {
        sum = 0u; cnt = 0u; mine = 0u;
#pragma unroll
        for (unsigned j = 0; j < 16; ++j) { const unsigned c = xb_ld(&bar[XB_XCNT(j)]); sum += c; cnt += (c > 0u) ? 1u : 0u; mine = (j == x) ? c : mine; }
        if (sum == G) break;
        __builtin_amdgcn_s_sleep(1);
        if ((++sp & 255u) == 0u) { if (xb_ld(&bar[XB_TMO])) break; if (sp > XB_SPIN_CAP) { atomicAdd(&bar[XB_TMO], 1u); break; } }
    }
    nloc = mine > 0u ? mine : 1u; nx = cnt > 0u ? cnt : 1u;
}
__device__ __forceinline__ void xcd_barrier(const XcdBarrier& b) {
    asm volatile("s_waitcnt vmcnt(0)" ::: "memory");
    __syncthreads();
    if (threadIdx.x == 0) {
        unsigned* bar = b.bar;
        __builtin_amdgcn_s_waitcnt(0);
        unsigned nloc = b.st[0], nx = b.st[1];
        if (nloc == 0u) { xcd_barrier_complete(bar, b.x, nloc, nx); b.st[0] = nloc; b.st[1] = nx; }
        const unsigned old = xb_add(&bar[XB_XSUB(b.x)], 1u);
        const unsigned gen = old / nloc;
        if (old + 1u == (gen + 1u) * nloc) {
            __builtin_amdgcn_fence(__ATOMIC_RELEASE, "agent");
            asm volatile("s_waitcnt vmcnt(0)" ::: "memory");
            const unsigned og = xb_add(&bar[XB_TOP], 1u);
            const unsigned tg = og / nx;
            if (og + 1u == (tg + 1u) * nx) xb_add(&bar[XB_TOPGEN], 1u);
            else XB_SPIN(xb_ld(&bar[XB_TOPGEN]) == tg, bar);
            __builtin_amdgcn_fence(__ATOMIC_ACQUIRE, "agent");
            xb_add(&bar[XB_XGEN(b.x)], 1u);
            asm volatile("s_waitcnt vmcnt(0)" ::: "memory");
        } else {
            XB_SPIN(xb_ld(&bar[XB_XGEN(b.x)]) == gen, bar);
            __builtin_amdgcn_fence(__ATOMIC_ACQUIRE, "agent");
            asm volatile("s_waitcnt vmcnt(0)" ::: "memory");
        }
    }
    __syncthreads();
}

__device__ __forceinline__ int opaque_lane() { int l; asm volatile("v_mbcnt_lo_u32_b32 %0, -1, 0\n\tv_mbcnt_hi_u32_b32 %0, -1, %0" : "=v"(l)); return l; }
__device__ __forceinline__ void dep_signal(unsigned* cnt, bool leader) {
    if (leader) { __builtin_amdgcn_fence(__ATOMIC_RELEASE, "agent"); asm volatile("s_waitcnt vmcnt(0)" ::: "memory"); (void)xb_add(cnt, 1u); }
}
__device__ __forceinline__ void dep_wait(unsigned* cnt, unsigned need, bool leader) {
    if (leader) { unsigned sp = 0; while (xb_ld(cnt) < need) { __builtin_amdgcn_s_sleep(2); if (++sp > (1u << 22)) break; }
        __builtin_amdgcn_fence(__ATOMIC_ACQUIRE, "agent"); asm volatile("s_waitcnt vmcnt(0)" ::: "memory"); }
    __syncthreads();
}
struct Args { const float* in[24]; float* out; unsigned char* ws; int ph_lo, ph_hi; };
typedef const __attribute__((address_space(4))) Args* ArgsP;
enum { I_XP = 0, I_XS, I_SCONV, I_SPOOL, I_CP, I_CS, I_NORMG, I_WADA, I_BADA, I_W1GU, I_W1DN, I_W2GU, I_W2DN, I_WIN, I_CONVW, I_WOA, I_LNG, I_WS, I_BS, I_WOB, I_POOLW, I_POOLS, I_WO, I_FNG };
constexpr int NPH = 3 + 8 * DEPTH + 1;

__device__ __forceinline__ void conv_item(const float* W, int K, int N, bf16_t* WT, int ldk, int mode, int rowoff, LAS float* scr, int item, int lane) {
    const int nblk = N / 32, kb = item / nblk, nb = item % nblk, k0 = 64 * kb, n0 = 32 * nb;
    const GAS float* rowp = (const GAS float*)W + (size_t)k0 * N + n0;
    const unsigned loff = (unsigned)((lane >> 5) * N + (lane & 31));
    float tv[32];
#pragma unroll
    for (int i = 0; i < 32; ++i) tv[i] = (rowp + (size_t)(2 * i) * N)[loff];
#pragma unroll
    for (int i = 0; i < 32; ++i) scr[(2 * i + (lane >> 5)) * 33 + (lane & 31)] = tv[i];
    LDS_WAIT();
    const int c = lane & 7;
#pragma unroll
    for (int j = 0; j < 4; ++j) { const int n = (lane >> 3) + 8 * j; const LAS float* s = scr + (8 * c) * 33 + n;
        u32x4 o; o.x = cvt_pk_bf16(s[0 * 33], s[1 * 33]); o.y = cvt_pk_bf16(s[2 * 33], s[3 * 33]); o.z = cvt_pk_bf16(s[4 * 33], s[5 * 33]); o.w = cvt_pk_bf16(s[6 * 33], s[7 * 33]);
        int nn = n0 + n;
        if (mode == 1) { const int half = nn >= DFF ? 1 : 0, jj = nn - half * DFF; nn = (jj >> 7) * 256 + half * 128 + (jj & 127); }
        *(GAS u32x4*)(WT + (size_t)(rowoff + nn) * ldk + k0 + 8 * c) = o; }
    LDS_WAIT();
}
constexpr int IT_GU = 16 * 176, IT_DN = 44 * 32, IT_IN = 16 * 192, IT_OA = 8 * 32, IT_PL = 64, IT_WO = 16 * 32, IT_ADA = 16 * 288;
constexpr int IT_LAYER = 2 * IT_GU + 2 * IT_DN + IT_IN + 2 * IT_OA + IT_PL + IT_WO + IT_ADA;

__device__ __forceinline__ void phase_prologue(ArgsP a, LAS unsigned char* lds, int gw, int NGW, int wave, int lane) {
    unsigned char* ws = a->ws;
    LAS float* scr = (LAS float*)(lds + wave * 16384);
    for (int it = gw; it < DEPTH * IT_LAYER; it += NGW) {
        const int l = it / IT_LAYER; int r = it - l * IT_LAYER;
        bf16_t* LW = (bf16_t*)(ws + WS_W + (size_t)l * LW_SIZE);
        if (r < IT_GU) { conv_item(a->in[I_W1GU] + (size_t)l * 1024 * 5632, 1024, 5632, LW + LW_GU1 / 2, 1024, 1, 0, scr, r, lane); continue; } r -= IT_GU;
        if (r < IT_DN) { conv_item(a->in[I_W1DN] + (size_t)l * 2816 * 1024, 2816, 1024, LW + LW_DN1 / 2, 2816, 0, 0, scr, r, lane); continue; } r -= IT_DN;
        if (r < IT_GU) { conv_item(a->in[I_W2GU] + (size_t)l * 1024 * 5632, 1024, 5632, LW + LW_GU2 / 2, 1024, 1, 0, scr, r, lane); continue; } r -= IT_GU;
        if (r < IT_DN) { conv_item(a->in[I_W2DN] + (size_t)l * 2816 * 1024, 2816, 1024, LW + LW_DN2 / 2, 2816, 0, 0, scr, r, lane); continue; } r -= IT_DN;
        if (r < IT_IN) { conv_item(a->in[I_WIN] + (size_t)l * 1024 * 6144, 1024, 6144, LW + LW_IN / 2, 1024, 0, 0, scr, r, lane); continue; } r -= IT_IN;
        if (r < IT_OA) { conv_item(a->in[I_WOA] + (size_t)l * 512 * 1024, 512, 1024, LW + LW_OA / 2, 512, 0, 0, scr, r, lane); continue; } r -= IT_OA;
        if (r < IT_OA) { conv_item(a->in[I_WOB] + (size_t)l * 512 * 1024, 512, 1024, LW + LW_OB / 2, 512, 0, 0, scr, r, lane); continue; } r -= IT_OA;
        if (r < IT_PL) { const int g = r >> 4; conv_item(a->in[I_POOLW] + (size_t)(l * 4 + g) * 128 * 256, 128, 256, LW + LW_PL / 2, 128, 0, g * 256, scr, r & 15, lane); continue; } r -= IT_PL;
        if (r < IT_WO) { conv_item(a->in[I_WO] + (size_t)l * 1024 * 1024, 1024, 1024, LW + LW_WO / 2, 1024, 0, 0, scr, r, lane); continue; } r -= IT_WO;
        conv_item(a->in[I_WADA] + (size_t)l * 1024 * 9216, 1024, 9216, (bf16_t*)(ws + WS_ADAW), 1024, 0, l * 9216, scr, r, lane);
    }
    const int gt = gw * 64 + lane, NGT = NGW * 64;
    { GAS unsigned* CA = (GAS unsigned*)(ws + WS_CA);
      for (int i = gt; i < 256 * 512; i += NGT) { const int b = i >> 9, k = (i & 511) * 2; float v0 = 0.f, v1 = 0.f;
        if (b < NBATCH) { const float* c = b < 8 ? a->in[I_CP] + (size_t)b * D : a->in[I_CS] + (size_t)(b - 8) * D; v0 = fast_silu(c[k]); v1 = fast_silu(c[k + 1]); }
        CA[i] = cvt_pk_bf16(v0, v1); } }
    { const GAS f32x2* sp = (const GAS f32x2*)a->in[I_SPOOL]; GAS unsigned* hp = (GAS unsigned*)(ws + WS_HISTP);
      for (int i = gt; i < DEPTH * 128 * 15 * 256; i += NGT) { const f32x2 v = sp[i]; hp[i] = cvt_pk_bf16(v.x, v.y); }
      const GAS f32x2* sc = (const GAS f32x2*)a->in[I_SCONV]; GAS unsigned* hc = (GAS unsigned*)(ws + WS_HISTC);
      for (int i = gt; i < DEPTH * 128 * 2 * 256; i += NGT) { const f32x2 v = sc[i]; hc[i] = cvt_pk_bf16(v.x, v.y); } }
    for (int i = gt; i < DEPTH * 8 * 128 * 64; i += NGT) { const int s = (i & 63) * 2, t = (i >> 6) & 127, lh = i >> 13, l = lh >> 3;
        const float* W = a->in[I_WS] + (size_t)lh * 128 * 128; bf16_t* LW = (bf16_t*)(ws + WS_W + (size_t)l * LW_SIZE);
        const float w0 = W[t * 128 + s], w1 = W[t * 128 + s + 1];
        ((GAS unsigned*)(LW + LW_TRIL / 2))[(size_t)(lh & 7) * 8192 + t * 64 + (s >> 1)] = cvt_pk_bf16(s <= t ? w0 : 0.f, s + 1 <= t ? w1 : 0.f);
        const int t8 = t & 7, s8 = s & 7; const bool same = (t >> 3) == (s >> 3);
        const float z0 = (same && s8 <= t8) ? W[t8 * 128 + s8] : 0.f, z1 = (same && s8 + 1 <= t8) ? W[t8 * 128 + s8 + 1] : 0.f;
        ((GAS unsigned*)(LW + LW_SAMP / 2))[(size_t)(lh & 7) * 8192 + t * 64 + (s >> 1)] = cvt_pk_bf16(z0, z1); }
}

__device__ __forceinline__ void phase_prep0(ArgsP a, int gw, int NGW, int lane) {
    const float* MOD = (const float*)(a->ws + WS_MOD); bf16_t* H = (bf16_t*)(a->ws + WS_H); ssq_t* SSQ = (ssq_t*)(a->ws + WS_SSQ);
    for (int row = gw; row < T; row += NGW) {
        const GAS f32x4* xr = (const GAS f32x4*)(row < TP ? a->in[I_XP] + (size_t)row * D : a->in[I_XS] + (size_t)(row - TP) * D) + lane;
        const float* mrow = MOD + (size_t)row_batch(row) * 36864 + D;
        GAS u32x2* o = (GAS u32x2*)(H + (size_t)row * D) + lane;
        float s = 0.f;
#pragma unroll
        for (int j = 0; j < 4; ++j) { const f32x4 v = xr[64 * j]; s += (v.x * v.x + v.y * v.y) + (v.z * v.z + v.w * v.w);
            const f32x4 h = v * *(const GAS f32x4*)(mrow + 4 * lane + 256 * j); u32x2 w; w.x = cvt_pk_bf16(h.x, h.y); w.y = cvt_pk_bf16(h.z, h.w); o[64 * j] = w; }
        s = wave_sum(s, lane);
        if (lane == 0) SSQ[row] = (ssq_t)(s * SSQ_SCALE + 0.5f);
    }
}
__device__ __forceinline__ void phase_final(ArgsP a, int gw, int NGW, int lane) {
    const bf16_t* X = (const bf16_t*)(a->ws + WS_H); const float* g = a->in[I_FNG]; const ssq_t* SSQ = (const ssq_t*)(a->ws + WS_SSQ) + (size_t)12 * T;
    f32x4 gv[4];
#pragma unroll
    for (int j = 0; j < 4; ++j) gv[j] = *(const GAS f32x4*)(g + 4 * lane + 256 * j);
    for (int row = gw; row < T; row += NGW) {
        const GAS u32x2* xr = (const GAS u32x2*)(X + (size_t)row * D) + lane;
        const float rstd = row_rstd(SSQ, row);
        GAS f32x4* o = (GAS f32x4*)(a->out + (size_t)row * D) + lane;
#pragma unroll
        for (int j = 0; j < 4; ++j) { const u32x2 w = xr[64 * j]; const f32x4 xv = (f32x4){bf_lo(w.x), bf_hi(w.x), bf_lo(w.y), bf_hi(w.y)}; o[64 * j] = (xv * rstd) * gv[j]; }
    }
}

__device__ __forceinline__ void gmlp_unit(ArgsP a, LAS unsigned char* lds, int l, int c, int wave, int lane) {
    const bf16_t* P = (const bf16_t*)(a->ws + WS_PA); bf16_t* Y = (bf16_t*)(a->ws + WS_YAB); float* out = a->out;
    const bf16_t* LW = (const bf16_t*)(a->ws + WS_W + (size_t)l * LW_SIZE);
    const int r0 = 128 * c; const bool samp = c >= 128;
    LAS bf16_t* vT = (LAS bf16_t*)lds;
    bf16x8 wfr[20];
    { const int fr = lane & 15, fq = lane >> 4; const bf16_t* Wh = LW + (samp ? LW_SAMP : LW_TRIL) / 2 + (size_t)wave * 128 * 128 + fr * 128 + 8 * fq;
      int wi = 0;
#pragma unroll
      for (int ks = 0; ks < 4; ++ks)
#pragma unroll
          for (int mt = 0; mt < 8; ++mt) if (mt >= 2 * ks) { wfr[wi] = *(const GAS bf16x8*)(Wh + (16 * mt) * 128 + 32 * ks); ++wi; } }
    { float lng[8];
      { const f32x4 g0 = *(const GAS f32x4*)(a->in[I_LNG] + l * 512 + 8 * lane), g1 = *(const GAS f32x4*)(a->in[I_LNG] + l * 512 + 8 * lane + 4);
        lng[0] = g0[0]; lng[1] = g0[1]; lng[2] = g0[2]; lng[3] = g0[3]; lng[4] = g1[0]; lng[5] = g1[1]; lng[6] = g1[2]; lng[7] = g1[3]; }
      const bf16_t* Pw = P + (size_t)(r0 + wave * 16) * 3072; const unsigned l8 = 8u * (unsigned)lane;
      u32x4 raw[16];
#pragma unroll
      for (int i = 0; i < 16; ++i) raw[i] = *(const GAS u32x4*)(Pw + i * 3072 + 2048 + l8);
#pragma unroll
      for (int i = 0; i < 16; ++i) { const int rl = wave * 16 + i, row = r0 + rl; float v[8];
        unpack8(raw[i], v);
        float s = 0.f;
#pragma unroll
        for (int j = 0; j < 8; ++j) s += v[j];
        const float mean = wave_sum(s, lane) * (1.f / 512.f); float q = 0.f;
#pragma unroll
        for (int j = 0; j < 8; ++j) { v[j] -= mean; q += v[j] * v[j]; }
        const float rstd = __builtin_amdgcn_rsqf(wave_sum(q, lane) * (1.f / 512.f) + EPS);
#pragma unroll
        for (int j = 0; j < 8; ++j) v[j] = v[j] * rstd * lng[j];
        if (samp) { float* o = out + O_V + (size_t)l * (128 * 8 * 512) + (size_t)(row - TP) * 512;
            *(GAS f32x4*)(o + l8) = (f32x4){v[0], v[1], v[2], v[3]}; *(GAS f32x4*)(o + 4 + l8) = (f32x4){v[4], v[5], v[6], v[7]}; }
        const u32x4 pk = pack8(v);
        LAS bf16_t* d = vT + (8 * lane) * VT_PITCH + ((((rl >> 3) ^ lane) & 15) << 3) + (rl & 7);
        d[0 * VT_PITCH] = (bf16_t)(pk.x & 0xffff); d[1 * VT_PITCH] = (bf16_t)(pk.x >> 16); d[2 * VT_PITCH] = (bf16_t)(pk.y & 0xffff); d[3 * VT_PITCH] = (bf16_t)(pk.y >> 16);
        d[4 * VT_PITCH] = (bf16_t)(pk.z & 0xffff); d[5 * VT_PITCH] = (bf16_t)(pk.z >> 16); d[6 * VT_PITCH] = (bf16_t)(pk.w & 0xffff); d[7 * VT_PITCH] = (bf16_t)(pk.w >> 16); }
    }
    __syncthreads();
    { const int h = wave, fr = lane & 15, fq = lane >> 4;
      f32x4 acc[8][4];
#pragma unroll
      for (int mt = 0; mt < 8; ++mt)
#pragma unroll
          for (int nt = 0; nt < 4; ++nt) acc[mt][nt] = (f32x4){0.f, 0.f, 0.f, 0.f};
      int wi = 0;
#pragma unroll
      for (int ks = 0; ks < 4; ++ks) { bf16x8 vf[4];
#pragma unroll
          for (int nt = 0; nt < 4; ++nt) { const int dd = h * 64 + 16 * nt + fr; vf[nt] = *(const LAS bf16x8*)(vT + dd * VT_PITCH + ((((4 * ks + fq) ^ (dd >> 3)) & 15) << 3)); }
#pragma unroll
          for (int mt = 0; mt < 8; ++mt) if (mt >= 2 * ks) { const bf16x8 wf = wfr[wi]; ++wi;
#pragma unroll
              for (int nt = 0; nt < 4; ++nt) acc[mt][nt] = __builtin_amdgcn_mfma_f32_16x16x32_bf16(vf[nt], wf, acc[mt][nt], 0, 0, 0); } }
      const float* bs = a->in[I_BS] + (size_t)(l * 8 + h) * 128;
#pragma unroll
      for (int mt = 0; mt < 8; ++mt) { const int t = 16 * mt + fr, row = r0 + t; const float bias = bs[samp ? (t & 7) : t];
          u32x2 ur[4];
#pragma unroll
          for (int nt = 0; nt < 4; ++nt) ur[nt] = *(const GAS u32x2*)(P + (size_t)row * 3072 + 1536 + h * 64 + 16 * nt + 4 * fq);
#pragma unroll
          for (int nt = 0; nt < 4; ++nt) { const int d = h * 64 + 16 * nt + 4 * fq;
              u32x2 w; w.x = cvt_pk_bf16((acc[mt][nt][0] + bias) * bf_lo(ur[nt].x), (acc[mt][nt][1] + bias) * bf_hi(ur[nt].x));
              w.y = cvt_pk_bf16((acc[mt][nt][2] + bias) * bf_lo(ur[nt].y), (acc[mt][nt][3] + bias) * bf_hi(ur[nt].y));
              *(GAS u32x2*)(Y + (size_t)row * D + 512 + d) = w; } }
    }
    __syncthreads();
}
__device__ __forceinline__ void convpool_unit(ArgsP a, int l, int cu, int wave, int lane) {
    const bf16_t* P = (const bf16_t*)(a->ws + WS_PA); bf16_t* Y = (bf16_t*)(a->ws + WS_YAB); bf16_t* YC = (bf16_t*)(a->ws + WS_YC); float* out = a->out;
    const int r0 = 32 * cu + 4 * wave; const bool samp = r0 >= TP;
    const int tpos0 = samp ? ((r0 - TP) & 7) : (r0 & 2047), sq = samp ? ((r0 - TP) >> 3) : (r0 >> 11), L = samp ? 8 : 2048; const unsigned d = 8u * (unsigned)lane;
    const bf16_t* Pr = P + (size_t)r0 * 3072;
    bf16_t* Yr = Y + (size_t)r0 * D; bf16_t* YCr = YC + (size_t)r0 * 512;
    { u32x4 xa[6], cg[6], bg[4];
      const bf16_t* hc = (const bf16_t*)(a->ws + WS_HISTC) + (size_t)(l * 128 + sq) * 2 * 512;
#pragma unroll
      for (int k = 0; k < 6; ++k) { const int tp = tpos0 - 2 + k;
          if (tp >= 0) { xa[k] = *(const GAS u32x4*)(Pr + (k - 2) * 3072 + d); cg[k] = *(const GAS u32x4*)(Pr + (k - 2) * 3072 + 1024 + d); }
          else if (samp) { xa[k] = *(const GAS u32x4*)(hc + (2 + tp) * 512 + d); cg[k] = (u32x4){0x3f803f80u, 0x3f803f80u, 0x3f803f80u, 0x3f803f80u}; }
          else { xa[k] = (u32x4){0u, 0u, 0u, 0u}; cg[k] = xa[k]; } }
#pragma unroll
      for (int j = 0; j < 4; ++j) bg[j] = *(const GAS u32x4*)(Pr + j * 3072 + 512 + d);
      float cw[3][8];
#pragma unroll
      for (int k = 0; k < 3; ++k) { const float* cwp = a->in[I_CONVW] + (size_t)(l * 3 + k) * 512; const f32x4 c0 = *(const GAS f32x4*)(cwp + d), c1 = *(const GAS f32x4*)(cwp + 4 + d);
          cw[k][0] = c0[0]; cw[k][1] = c0[1]; cw[k][2] = c0[2]; cw[k][3] = c0[3]; cw[k][4] = c1[0]; cw[k][5] = c1[1]; cw[k][6] = c1[2]; cw[k][7] = c1[3]; }
      float ci[6][8];
#pragma unroll
      for (int k = 0; k < 6; ++k) { float x8[8], c8[8]; unpack8(xa[k], x8); unpack8(cg[k], c8);
#pragma unroll
          for (int q = 0; q < 8; ++q) ci[k][q] = c8[q] * x8[q]; }
#pragma unroll
      for (int j = 0; j < 4; ++j) { float b8[8], ya[8]; unpack8(bg[j], b8);
#pragma unroll
          for (int q = 0; q < 8; ++q) ya[q] = b8[q] * (cw[0][q] * ci[j][q] + cw[1][q] * ci[j + 1][q] + cw[2][q] * ci[j + 2][q]);
          *(GAS u32x4*)(Yr + j * D + d) = pack8(ya); }
      if (tpos0 == L - 4) {
#pragma unroll
          for (int j = 2; j < 4; ++j) { float* o = out + (samp ? O_CS : O_CP) + ((size_t)(l * (samp ? 128 : 8) + sq) * 2 + (j - 2)) * 512;
              *(GAS f32x4*)(o + d) = (f32x4){ci[j + 2][0], ci[j + 2][1], ci[j + 2][2], ci[j + 2][3]}; *(GAS f32x4*)(o + 4 + d) = (f32x4){ci[j + 2][4], ci[j + 2][5], ci[j + 2][6], ci[j + 2][7]}; } }
    }
    { const int w = 2 << (lane >> 4);
      const bf16_t* hp = (const bf16_t*)(a->ws + WS_HISTP) + (size_t)(l * 128 + sq) * 15 * 512;
      u32x4 raw[19];
#pragma unroll
      for (int i = 0; i < 19; ++i) { const int tp = tpos0 + 3 - i; raw[i] = (u32x4){0u, 0u, 0u, 0u};
          if (i < 5 || i < w + 3) {
              if (tp >= 0) raw[i] = *(const GAS u32x4*)(Pr + (3 - i) * 3072 + 2560 + d);
              else if (samp) raw[i] = *(const GAS u32x4*)(hp + (15 + tp) * 512 + d); } }
      float o[4][8], pc[4][8];
#pragma unroll
      for (int j = 0; j < 4; ++j)
#pragma unroll
          for (int q = 0; q < 8; ++q) { o[j][q] = 0.f; pc[j][q] = 0.f; }
#pragma unroll
      for (int i = 0; i < 19; ++i) { float p8[8]; unpack8(raw[i], p8);
#pragma unroll
          for (int j = 0; j < 4; ++j) { const int ii = i - 3 + j;
              if (ii >= 0 && ii < 16) { const float m = ii < w ? 1.f : 0.f;
#pragma unroll
                  for (int q = 0; q < 8; ++q) o[j][q] += m * p8[q]; }
              if (ii == 0) {
#pragma unroll
                  for (int q = 0; q < 8; ++q) pc[j][q] = p8[q]; } } }
#pragma unroll
      for (int j = 0; j < 4; ++j) { const int tpos = tpos0 + j; const float inv = 1.0f / (float)(samp ? w : (tpos + 1 < w ? tpos + 1 : w)); float yc[8];
#pragma unroll
          for (int q = 0; q < 8; ++q) yc[q] = o[j][q] * inv - pc[j][q];
          *(GAS u32x4*)(YCr + j * 512 + d) = pack8(yc);
          if (samp) { float* oo = out + O_PS + ((size_t)(l * 128 + sq) * 15 + 7 + tpos) * 512;
              *(GAS f32x4*)(oo + d) = (f32x4){pc[j][0], pc[j][1], pc[j][2], pc[j][3]}; *(GAS f32x4*)(oo + 4 + d) = (f32x4){pc[j][4], pc[j][5], pc[j][6], pc[j][7]}; }
          else if (tpos >= 2048 - 15) { float* oo = out + O_PP + ((size_t)(l * 8 + sq) * 15 + (tpos - (2048 - 15))) * 512;
              *(GAS f32x4*)(oo + d) = (f32x4){pc[j][0], pc[j][1], pc[j][2], pc[j][3]}; *(GAS f32x4*)(oo + 4 + d) = (f32x4){pc[j][4], pc[j][5], pc[j][6], pc[j][7]}; } }
      if (samp && tpos0 == 0) {
#pragma unroll
          for (int i = 0; i < 7; ++i) { const float* sp = a->in[I_SPOOL] + ((size_t)(l * 128 + sq) * 15 + 8 + i) * 512; float* o2 = out + O_PS + ((size_t)(l * 128 + sq) * 15 + i) * 512;
              *(GAS f32x4*)(o2 + d) = *(const GAS f32x4*)(sp + d); *(GAS f32x4*)(o2 + 4 + d) = *(const GAS f32x4*)(sp + 4 + d); } }
    }
}

__global__ void __launch_bounds__(512, 2) fwd(Args a_) {
    extern __shared__ __attribute__((aligned(16))) unsigned char lds_raw[];
    LAS unsigned char* lds = (LAS unsigned char*)lds_raw;
    const int G = gridDim.x, bx = blockIdx.x;
#if ONE_LAUNCH
    volatile LAS unsigned* MISC = (volatile LAS unsigned*)(lds + MISC_OFF);
    if (threadIdx.x < 64) MISC[threadIdx.x] = 0u;
    __syncthreads();
    (void)xcd_barrier_post((unsigned*)(a_.ws + WS_CTL) + 4096, MISC + 8);
#endif
    const int ph_lo = a_.ph_lo, ph_hi = a_.ph_hi;
    const int wave0 = __builtin_amdgcn_readfirstlane(threadIdx.x >> 6);
#if ONE_LAUNCH
    if (ph_lo > ph_hi) cg::this_grid().sync();
#endif
    int redo = 0;
    for (int ph = ph_lo; ph < ph_hi; ++ph) {
        ArgsP a = (ArgsP)__builtin_amdgcn_kernarg_segment_ptr(); asm volatile("" : "+s"(a));
        int wave = wave0; asm volatile("" : "+s"(wave));
#define TID() (wave * 64 + opaque_lane())
        unsigned char* ws = a->ws; asm volatile("" : "+s"(ws));
        const int gw = bx * 8 + wave, NGW = G * 8;
        float* MOD = (float*)(ws + WS_MOD); ssq_t* SSQ = (ssq_t*)(ws + WS_SSQ); float* SB = (float*)(ws + WS_SB);
        constexpr size_t TSTEP1K = (size_t)256 * 1024 * 2;
        if (ph == 0) phase_prologue(a, lds, gw, NGW, wave, opaque_lane());
        else if (ph == 1) {
            pg8::Gemm g{(const bf16_t*)(ws + WS_CA), (const bf16_t*)(ws + WS_ADAW), 1024, 1024, 1024, 0, 0, 0}; pg8::StaticOrder S; S.init(1, 36864 / 256, G, bx);
            EpiAda E{MOD, a->in[I_BADA], a->in[I_NORMG], (bf16_t*)(ws + WS_SH)};
            pg8::gemm_phase<EpiAda, pg8::StaticOrder>(lds, g, S, E, TID());
        } else if (ph == 2) {
            for (int sidx = 0; sidx < 3; ++sidx) { const int tid2 = TID();
                pg8::Gemm g{(const bf16_t*)(ws + WS_SH) + (size_t)sidx * 256 * 1024, (const bf16_t*)(ws + WS_W + (sidx == 0 ? LW_GU1 : (sidx == 1 ? LW_IN : LW_GU2))), 1024, 1024, 1024, 0, 3 * TSTEP1K, LW_SIZE};
                pg8::StaticOrder S; S.init(0, 4, sidx == 1 ? 24 : 22, G, bx, sidx == 0 ? 0 : (sidx == 1 ? 88 : 184), sidx == 0 ? 88 : (sidx == 1 ? 96 : 72), 0, 0);
                EpiSB E{SB, sidx == 0 ? 0 : (sidx == 1 ? 5632 : 11776)};
                pg8::gemm_phase<EpiSB, pg8::StaticOrder>(lds, g, S, E, tid2);
            }
            phase_prep0(a, gw, NGW, opaque_lane());
        } else if (ph == NPH - 1) phase_final(a, gw, NGW, opaque_lane());
        else {
            const int l = (ph - 3) >> 3, k = (ph - 3) & 7;
            const bf16_t* LW = (const bf16_t*)(ws + WS_W + (size_t)l * LW_SIZE);
            unsigned* DEP = (unsigned*)(ws + WS_CTL) + 8192 + 64 * 2 * (l * 8 + k);
            bf16_t* GSv = (bf16_t*)(ws + WS_GS) - (size_t)TP * DFF; bf16_t* MGSv = (bf16_t*)(ws + WS_MGS) - (size_t)TP * D;
            if (k == 3) {
                if (bx < T / 128) gmlp_unit(a, lds, l, bx, wave, opaque_lane());
                else for (int u = bx - T / 128; u < T / 32; u += G - T / 128) convpool_unit(a, l, u, wave, opaque_lane());
            } else {
                const bool lastl = (l == DEPTH - 1);
                const int nsteps = (k == 0) ? 2 : (k == 2) ? 5 : (k == 6) ? (lastl ? 6 : 4) : 1;
                for (int st = 0; st < nsteps; ++st) {
                    int ek = 0, samp = 0, jl = l, jsub = 0, nN = 4, cu_off = 0, cu_cnt = G, skc = 0, skr = 0, sig = -1, wt = -1, gu2 = 0, ri0 = 0, rend = 1 << 20, lofs = 0; unsigned wneed = 16u;
                    if (k == 0) { if (st == 0) { if (l > 0) { ek = 2; samp = 1; jl = l - 1; jsub = 2; cu_cnt = 16; sig = 0; } }
                                  else { ek = 1; nN = 22; if (l > 0) { skc = 16; skr = 3; } } }
                    else if (k == 1) { ek = 2; jsub = 0; }
                    else if (k == 2) { if (st == 0) { ek = 1; samp = 1; nN = 22; cu_off = 16; cu_cnt = 88; sig = 0; }
                                       else if (st == 1) { ek = 2; samp = 1; jsub = 0; cu_cnt = 16; wt = 0; wneed = 88u; sig = 1; }
                                       else if (st == 2) { ek = 3; nN = 24; cu_off = 104; cu_cnt = 152; rend = 1; }
                                       else if (st == 3) { ek = 3; nN = 24; skc = 16; skr = 3; lofs = 152; }
                                       else { ek = 3; samp = 1; nN = 24; cu_off = 160; cu_cnt = 96; wt = 1; } }
                    else if (k == 4) { ek = 4; }
                    else if (k == 5) { ek = 2; jsub = 1; }
                    else if (k == 6 && !lastl) { if (st == 0) { ek = 4; samp = 1; cu_cnt = 16; sig = 0; }
                                       else if (st == 1) { ek = 2; samp = 1; jsub = 1; cu_cnt = 16; wt = 0; sig = 1; }
                                       else if (st == 2) { ek = 1; gu2 = 1; nN = 22; skc = 16; skr = 4; }
                                       else { ek = 1; gu2 = 1; samp = 1; nN = 22; cu_off = 168; cu_cnt = 88; wt = 1; } }
                    else if (k == 6) {
                                       if (st == 0) { ek = 4; samp = 1; cu_cnt = 16; sig = 0; }
                                       else if (st == 1) { ek = 2; samp = 1; jsub = 1; cu_cnt = 16; wt = 0; sig = 1; }
                                       else if (st == 2) { ek = 1; gu2 = 1; nN = 22; skc = 16; skr = 5; rend = 3; }
                                       else if (st == 3) { ek = 1; gu2 = 1; samp = 1; nN = 22; cu_off = 168; cu_cnt = 88; wt = 1; sig = 2; }
                                       else if (st == 4) { ek = 1; gu2 = 1; nN = 22; skc = 16; skr = 5; ri0 = 3; }
                                       else { ek = 2; samp = 1; jsub = 2; cu_cnt = 16; wt = 2; wneed = 88u; } }
                    else { ek = 2; jsub = 2; }
                    if (ek == 0) continue;
                    pg8::StaticOrder S; S.init(samp ? 64 : 0, samp ? 4 : 64, nN, G, bx, cu_off, cu_cnt, skc, skr, ri0, rend, lofs);
                    pg8::Unit u0; const bool mine = S.next(0, u0);
                    const bool leader = (TID() == 0);
                    if (wt >= 0 && mine) dep_wait(DEP + 64 * wt, wneed, leader);
                    const bf16_t* JW = (const bf16_t*)(ws + WS_W + (size_t)jl * LW_SIZE);
                    if (ek == 1) {
                        pg8::Gemm g{(const bf16_t*)(ws + WS_H), LW + (gu2 ? LW_GU2 : LW_GU1) / 2, 1024, 1024, 1024, 0, TSTEP1K, 0};
                        EpiSwiglu E{(bf16_t*)(ws + WS_G), GSv, SSQ + (size_t)(3 * l + (gu2 ? 2 : 0)) * T, SB + l * SB_LAYER + (gu2 ? 11776 : 0)};
                        pg8::gemm_phase<EpiSwiglu, pg8::StaticOrder>(lds, g, S, E, TID());
                    } else if (ek == 2) {
                        pg8::Gemm g; float sc;
                        if (jsub == 1) { g = pg8::Gemm{samp ? (const bf16_t*)MGSv : (const bf16_t*)(ws + WS_MG), JW + LW_WO / 2, 1024, 1024, 1024, 0, TSTEP1K, 0}; sc = 1.0f; }
                        else { g = pg8::Gemm{samp ? (const bf16_t*)GSv : (const bf16_t*)(ws + WS_G), JW + (jsub == 0 ? LW_DN1 : LW_DN2) / 2, DFF, DFF, DFF, 0, (size_t)256 * DFF * 2, 0}; sc = 0.5f; }
                        const int nsub = jsub == 2 ? 0 : jsub + 1, nl = jsub == 2 ? (jl == DEPTH - 1 ? jl : jl + 1) : jl; const int fin = (jsub == 2 && jl == DEPTH - 1) ? 1 : 0;
                        EpiResid E{MOD + jl * NADA + (jsub * 3 + 2) * D, MOD + jl * NADA + (jsub * 3 + 1) * D, MOD + nl * NADA + (nsub * 3 + 1) * D, (bf16_t*)(ws + WS_H), SSQ + (size_t)(3 * jl + jsub + 1) * T, sc, fin};
                        pg8::gemm_phase<EpiResid, pg8::StaticOrder>(lds, g, S, E, TID());
                    } else if (ek == 3) {
                        pg8::Gemm g{(const bf16_t*)(ws + WS_H), LW + LW_IN / 2, 1024, 1024, 1024, 0, TSTEP1K, 0};
                        EpiProj E{(bf16_t*)(ws + WS_PA), (bf16_t*)(ws + WS_PG), SSQ + (size_t)(3 * l + 1) * T, SB + l * SB_LAYER + 5632};
                        pg8::gemm_phase<EpiProj, pg8::StaticOrder>(lds, g, S, E, TID());
                    } else {
                        const pg8::Gemm gj[3] = { pg8::Gemm{(const bf16_t*)(ws + WS_YAB), LW + LW_OA / 2, 1024, 512, 512, 0, TSTEP1K, 0},
                                                  pg8::Gemm{(const bf16_t*)(ws + WS_YAB) + 512, LW + LW_OB / 2, 1024, 512, 512, 0, TSTEP1K, 0},
                                                  pg8::Gemm{(const bf16_t*)(ws + WS_YC), LW + LW_PL / 2, 512, 128, 128, 128, (size_t)256 * 512 * 2, 0} };
                        EpiMix E{(bf16_t*)(ws + WS_MG), MGSv, (const bf16_t*)(ws + WS_PG), a->in[I_POOLS] + (size_t)l * D};
                        pg8::gemm_phase3<EpiMix, pg8::StaticOrder>(lds, gj, S, E, TID());
                    }
                    if (sig >= 0 && mine) dep_signal(DEP + 64 * sig, leader);
                }
            }
        }
#if ONE_LAUNCH
        if (PROBE_PRE && ph < 3 && ((PROBE_PRE >> ph) & 1)) { if (!redo) { redo = 1; --ph; } else redo = 0; }
        if (PROBE_MASK && ph >= 3 && ph < NPH - 1 && ((PROBE_MASK >> ((ph - 3) & 7)) & 1)) { if (!redo) { redo = 1; --ph; } else redo = 0; }
        if (ph + 1 < ph_hi) { XcdBarrier bar; bar.bar = (unsigned*)(ws + WS_CTL) + 4096; bar.x = xb_xcc_id(); bar.st = (volatile LAS unsigned*)(lds + MISC_OFF) + 8; xcd_barrier(bar); }
#endif
    }
}

extern "C" void kernel_launch(void* const* d_in, const int* in_sizes, int n_in, void* d_out, int out_size, void* d_ws, size_t ws_size, hipStream_t stream) {
    static int grid = 0;
    if (grid == 0) {
        if (n_in != 24 || (size_t)out_size != O_END || ws_size < WS_END) { fprintf(stderr, "kernel_launch: unexpected sizes n_in %d out %d ws %zu\n", n_in, out_size, ws_size); grid = -1; return; }
        int dev = 0, cus = 0;
        if (hipGetDevice(&dev) != hipSuccess || hipDeviceGetAttribute(&cus, hipDeviceAttributeMultiprocessorCount, dev) != hipSuccess) { grid = -1; return; }
        if (hipFuncSetAttribute((const void*)fwd, hipFuncAttributeMaxDynamicSharedMemorySize, LDS_BYTES) != hipSuccess) { fprintf(stderr, "kernel_launch: hipFuncSetAttribute failed\n"); grid = -1; return; }
        int per_cu = 0; (void)hipOccupancyMaxActiveBlocksPerMultiprocessor(&per_cu, (const void*)fwd, 512, LDS_BYTES); (void)hipGetLastError();
        grid = cus;
    }
    if (grid < 0) return;
    Args a{};
    for (int i = 0; i < 24; ++i) a.in[i] = (const float*)d_in[i];
    a.out = (float*)d_out; a.ws = (unsigned char*)d_ws;
#if ONE_LAUNCH
    (void)hipMemsetAsync((char*)d_ws + WS_CTL, 0, CTL_BYTES, stream);
    (void)hipMemsetAsync((char*)d_ws + WS_SSQ, 0, SSQ_BYTES, stream);
    a.ph_lo = 0; a.ph_hi = NPH;
    void* args[] = {&a};
    hipError_t e = hipLaunchCooperativeKernel((const void*)fwd, dim3(grid), dim3(512), args, LDS_BYTES, stream);
    if (e != hipSuccess) fprintf(stderr, "cooperative launch failed: %s (grid %d)\n", hipGetErrorString(e), grid);
#else
    for (int ph = 0; ph < NPH; ++ph) { a.ph_lo = ph; a.ph_hi = ph + 1; hipLaunchKernelGGL(fwd, dim3(grid), dim3(512), LDS_BYTES, stream, a); }
#endif
}
```

```cpp
#include <hip/hip_runtime.h>
#include <hip/hip_cooperative_groups.h>
#include <cstdio>
#include <cstdint>
namespace cg = cooperative_groups;

#define PROBE_PRE 0x0
#define PROBE_MASK 0x00
#ifndef ONE_LAUNCH
#define ONE_LAUNCH 1
#endif

#define GAS __attribute__((address_space(1)))
#define LAS __attribute__((address_space(3)))
typedef unsigned short bf16_t;
typedef short bf16x8 __attribute__((ext_vector_type(8)));
typedef float f32x4 __attribute__((ext_vector_type(4)));
typedef float f32x2 __attribute__((ext_vector_type(2)));
typedef unsigned u32x4 __attribute__((ext_vector_type(4)));
typedef unsigned u32x2 __attribute__((ext_vector_type(2)));

constexpr int D = 1024, TP = 16384, TS = 1024, T = TP + TS, NBATCH = 136, DEPTH = 4, DFF = 2816, NIN = 6144, NADA = 9216;
constexpr int NM = T / 256;
constexpr float EPS = 1e-6f;
constexpr size_t O_YP = 0, O_YS = 16777216, O_CP = 17825792, O_CS = 17858560, O_PP = 18382848, O_PS = 18628608, O_V = 22560768, O_END = 24657920;

constexpr size_t MiB = 1u << 20;
constexpr size_t WS_CTL = 0, CTL_BYTES = 1 * MiB;
constexpr size_t LW_GU1 = 0, LW_DN1 = LW_GU1 + (size_t)5632 * 1024 * 2, LW_GU2 = LW_DN1 + (size_t)1024 * 2816 * 2, LW_DN2 = LW_GU2 + (size_t)5632 * 1024 * 2,
                 LW_IN = LW_DN2 + (size_t)1024 * 2816 * 2, LW_OA = LW_IN + (size_t)6144 * 1024 * 2, LW_OB = LW_OA + (size_t)1024 * 512 * 2, LW_PL = LW_OB + (size_t)1024 * 512 * 2,
                 LW_WO = LW_PL + (size_t)1024 * 128 * 2, LW_TRIL = LW_WO + (size_t)1024 * 1024 * 2, LW_SAMP = LW_TRIL + (size_t)8 * 128 * 128 * 2, LW_SIZE = LW_SAMP + (size_t)8 * 128 * 128 * 2;
static_assert(LW_SIZE == 52166656, "layer weight block");
constexpr size_t WS_W = 1 * MiB;
constexpr size_t WS_ADAW = 200 * MiB;
constexpr size_t WS_SB = WS_ADAW;
constexpr size_t WS_YC = WS_ADAW + 40 * MiB;
constexpr size_t WS_CA = 272 * MiB;
constexpr size_t WS_X = 273 * MiB;
constexpr size_t WS_YAB = WS_X;
constexpr size_t WS_H = 341 * MiB;
constexpr size_t WS_MOD = 375 * MiB;
constexpr size_t WS_R = 395 * MiB;
constexpr size_t WS_PA = WS_R, WS_PG = WS_R + 102 * MiB, WS_G = WS_R, WS_MG = WS_R, WS_SH = WS_R + 150 * MiB;
constexpr size_t WS_SSQ = 616 * MiB;
constexpr size_t SSQ_BYTES = (size_t)13 * T * 4;
constexpr size_t WS_HISTP = 599 * MiB;
constexpr size_t WS_HISTC = 607 * MiB;
constexpr size_t WS_GS = 608 * MiB;
constexpr size_t WS_MGS = 614 * MiB;
constexpr size_t WS_END = 618 * MiB;
constexpr int SB_LD = 69632, SB_LAYER = 17408;
static_assert(WS_W + 4 * LW_SIZE <= WS_ADAW && WS_SB + (size_t)136 * SB_LD * 4 <= WS_YC && WS_YC + (size_t)T * 512 * 2 <= WS_CA && WS_X + (size_t)T * 1024 * 4 <= WS_H && WS_H + (size_t)T * 1024 * 2 <= WS_MOD &&
              WS_MOD + (size_t)136 * 36864 * 4 <= WS_R && WS_PG + (size_t)T * 3072 * 2 <= WS_HISTP && WS_GS + (size_t)TS * DFF * 2 <= WS_MGS && WS_MGS + (size_t)TS * D * 2 <= WS_SSQ && WS_SSQ + SSQ_BYTES <= WS_END, "ws map");

constexpr int LDS_BYTES = 147456, MISC_OFF = LDS_BYTES - 256;
constexpr int VT_PITCH = 136;

#define LDS_WAIT() asm volatile("s_waitcnt lgkmcnt(0)" ::: "memory")
#define VM_WAIT() asm volatile("s_waitcnt vmcnt(0)" ::: "memory")

__device__ __forceinline__ unsigned cvt_pk_bf16(float lo, float hi) { unsigned r; asm volatile("v_cvt_pk_bf16_f32 %0, %1, %2" : "=v"(r) : "v"(lo), "v"(hi)); return r; }
__device__ __forceinline__ float bf_lo(unsigned u) { return __uint_as_float(u << 16); }
__device__ __forceinline__ float bf_hi(unsigned u) { return __uint_as_float(u & 0xffff0000u); }
__device__ __forceinline__ void unpack8(const u32x4 r, float (&v)[8]) { v[0] = bf_lo(r.x); v[1] = bf_hi(r.x); v[2] = bf_lo(r.y); v[3] = bf_hi(r.y); v[4] = bf_lo(r.z); v[5] = bf_hi(r.z); v[6] = bf_lo(r.w); v[7] = bf_hi(r.w); }
__device__ __forceinline__ u32x4 pack8(const float (&v)[8]) { u32x4 r; r.x = cvt_pk_bf16(v[0], v[1]); r.y = cvt_pk_bf16(v[2], v[3]); r.z = cvt_pk_bf16(v[4], v[5]); r.w = cvt_pk_bf16(v[6], v[7]); return r; }
__device__ __forceinline__ float fast_sigmoid(float x) { return __builtin_amdgcn_rcpf(1.0f + __builtin_amdgcn_exp2f(-1.44269504089f * x)); }
__device__ __forceinline__ float fast_silu(float x) { return x * fast_sigmoid(x); }
template <class Tp> __device__ __forceinline__ Tp* sel_ptr(bool c, Tp* a, Tp* b) { const unsigned long long ua = (unsigned long long)a, ub = (unsigned long long)b; return (Tp*)(ub ^ ((ua ^ ub) & (0ull - (unsigned long long)c))); }
__device__ __forceinline__ int row_batch(int r) { return r < TP ? (r >> 11) : 8 + ((r - TP) >> 3); }
__device__ __forceinline__ float wave_sum(float v, int lane) {
#pragma unroll
    for (int o = 1; o < 64; o <<= 1) v += __int_as_float(__builtin_amdgcn_ds_bpermute((lane ^ o) << 2, __float_as_int(v)));
    return v;
}
__device__ __forceinline__ f32x2 gelu_pk(f32x2 v) {
    const f32x2 av = __builtin_elementwise_abs(v), d = av * 0.2316418882f + 1.0f;
    f32x2 t; t.x = __builtin_amdgcn_rcpf(d.x); t.y = __builtin_amdgcn_rcpf(d.y);
    f32x2 q = t * 0.5307027145f + (-0.7265760135f); q = q * t + 0.7107068705f; q = q * t + (-0.142248368f); q = q * t + 0.127414796f; q = q * t;
    const f32x2 s = (v * v) * (-0.72134752044f);
    f32x2 e; e.x = __builtin_amdgcn_exp2f(s.x); e.y = __builtin_amdgcn_exp2f(s.y);
    const f32x2 m = v * (q * e), r = v - m;
    f32x2 o; o.x = v.x < 0.f ? m.x : r.x; o.y = v.y < 0.f ? m.y : r.y; return o;
}

namespace pg8 {
constexpr int BM = 256, BK = 64, HALF = 128, HTB = HALF * BK * 2, STAGE_BYTES = 8 * HTB, NXCD = 8, WGM = 8;
__host__ __device__ __forceinline__ int lds_byte(int r, int c) { const int st = (r >> 4) * 2 + (c >> 5), rr = r & 15, cc = c & 31, ob = rr * 64 + cc * 2; return st * 1024 + (ob ^ (((ob >> 9) & 1) << 5)); }
__host__ __device__ __forceinline__ void stage_rc(int b, int& R, int& C) { const int st = b / 1024, sb = b % 1024, swz = sb ^ (((sb >> 9) & 1) << 5); R = (st >> 1) * 16 + swz / 64; C = (st & 1) * 32 + (swz % 64) / 2; }
__host__ __device__ __forceinline__ int perm32(int rho) { const int n = rho >> 4, i = rho & 15; return 8 * (i >> 2) + 4 * n + (i & 3); }

struct Unit { int pm, pn, job; };
struct Gemm { const bf16_t* A; const bf16_t* Bt; int lda, ldb, K, a_pn_off; size_t a_pm_stride, b_pm_stride; };

struct StaticOrder {
    int pm0, nM, nN, nwg, Gp, v, skc, skr, i0, rend, lofs;
    __device__ void init(int pm0_, int nM_, int nN_, int G, int c, int cu_off, int cu_cnt, int skc_, int skr_, int i0_ = 0, int rend_ = 1 << 20, int lofs_ = 0) { pm0 = pm0_; lofs = lofs_; nM = nM_; nN = nN_; nwg = nM * nN; Gp = cu_cnt; skc = skc_; skr = skr_; i0 = i0_; rend = rend_;
        int vv = c - cu_off; if (vv < 0) vv += G; v = vv < cu_cnt ? vv : -1; }
    __device__ void init(int nM_, int nN_, int G, int c) { init(0, nM_, nN_, G, c, 0, G, 0, 0); }
    __device__ bool next(int i, Unit& u) const {
        if (v < 0) return false;
        const int r0 = v < skc ? skr : 0, r = (r0 > i0 ? r0 : i0) + i;
        if (r >= rend) return false;
        const long L = lofs + (r < skr ? (long)r * (Gp - skc) + (v - skc) : (long)skr * (Gp - skc) + (long)(r - skr) * Gp + v);
        if (L >= nwg) return false;
        int wgid = (int)L; { const int q = nwg / NXCD, r = nwg % NXCD, xcd = wgid % NXCD, off = wgid / NXCD; wgid = (xcd < r ? xcd * (q + 1) : r * (q + 1) + (xcd - r) * q) + off; }
        const int nig = WGM * nN, gid = wgid / nig, fm = gid * WGM, gsz = (nM - fm) < WGM ? (nM - fm) : WGM;
        u.pm = pm0 + fm + ((wgid % nig) % gsz); u.pn = (wgid % nig) / gsz; return true;
    }
    __device__ __forceinline__ void a_ready(const Unit&) const {}
    __device__ __forceinline__ void done(const Unit&) const {}
};

template <class Epi, class Sched>
__device__ __forceinline__ void gemm_phase(LAS unsigned char* lds, const Gemm g, const Sched& S, const Epi& E, const int tid) {
    const int wid = __builtin_amdgcn_readfirstlane(tid >> 6), lane = tid & 63, wr = wid >> 2, wc = wid & 3, fr = lane & 15, fq = lane >> 4;
    const int nt = g.K / BK;
    unsigned voffA[2], voffB[2];
#pragma unroll
    for (int i = 0; i < 2; ++i) { int R, C; stage_rc(tid * 16 + i * 8192, R, C); const int Rb = Epi::PERM ? ((R & ~31) + perm32(R & 31)) : R;
        voffA[i] = (unsigned)(R * g.lda + C) * 2u; voffB[i] = (unsigned)(Rb * g.ldb + C) * 2u; }
    const size_t kstep = (size_t)(BK * 2);
    const size_t hstepA = (size_t)HALF * g.lda * 2, hstepB = (size_t)HALF * g.ldb * 2;
    const size_t tstepB = 2 * hstepB;
    const size_t pnoffA = (size_t)g.a_pn_off * 2;
    const unsigned ldsw = (unsigned)wid * 1024u;
    const int aoff = lds_byte(wr * 64 + fr, fq * 8), boff = lds_byte(wc * 32 + fr, fq * 8);
#define PG8_SA(b, h) (((b) * 2 + (h)) * HTB)
#define PG8_SB(b, h) ((4 + (b) * 2 + (h)) * HTB)
#define PG8_STAGE(bufoff, gbase, voff) do { _Pragma("unroll") for (int _i = 0; _i < 2; ++_i) \
        __builtin_amdgcn_global_load_lds((const GAS unsigned*)((const char*)(gbase) + (voff)[_i]), (LAS unsigned*)(lds + (bufoff) + ldsw + _i * 8192), 16, 0, 0); } while (0)
#define PG8_LDA(dst, b, h) do { _Pragma("unroll") for (int m = 0; m < 4; ++m) _Pragma("unroll") for (int k = 0; k < 2; ++k) dst[m][k] = *(const LAS bf16x8*)(lds + PG8_SA(b, h) + aoff + m * 2048 + k * 1024); } while (0)
#define PG8_LDB(dst, b, h) do { _Pragma("unroll") for (int n = 0; n < 2; ++n) _Pragma("unroll") for (int k = 0; k < 2; ++k) dst[n][k] = *(const LAS bf16x8*)(lds + PG8_SB(b, h) + boff + n * 2048 + k * 1024); } while (0)
#define PG8_MMA(ai, bj, At, Bt) do { __builtin_amdgcn_s_setprio(1); _Pragma("unroll") for (int m = 0; m < 4; ++m) _Pragma("unroll") for (int n = 0; n < 2; ++n) _Pragma("unroll") for (int k = 0; k < 2; ++k) \
        acc[ai][bj][m][n] = __builtin_amdgcn_mfma_f32_16x16x32_bf16(Bt[n][k], At[m][k], acc[ai][bj][m][n], 0, 0, 0); __builtin_amdgcn_s_setprio(0); } while (0)
#define PG8_WAIT_V(n) asm volatile("s_waitcnt vmcnt(" #n ")" ::: "memory")
#define PG8_WAIT_L(n) asm volatile("s_waitcnt lgkmcnt(" #n ")" ::: "memory")
#define PG8_BAR __builtin_amdgcn_s_barrier()
#define PG8_SCHED __builtin_amdgcn_sched_barrier(0)
    Unit cur, nxt; int ui = 0;
    if (!S.next(0, cur)) return;
    f32x4 acc[2][2][4][2];
#pragma unroll
    for (int a = 0; a < 2; ++a)
#pragma unroll
        for (int b = 0; b < 2; ++b)
#pragma unroll
            for (int m = 0; m < 4; ++m)
#pragma unroll
                for (int n = 0; n < 2; ++n) acc[a][b][m][n] = (f32x4){0.f, 0.f, 0.f, 0.f};
    bf16x8 At[4][2], B0[2][2], B1[2][2];
    typename Epi::Pre pre = {};
    const char* cA = (const char*)g.A + (size_t)cur.pm * g.a_pm_stride + (size_t)cur.pn * pnoffA; const char* cB = (const char*)g.Bt + (size_t)cur.pn * tstepB + (size_t)cur.pm * g.b_pm_stride;
    S.a_ready(cur);
    PG8_STAGE(PG8_SB(0, 0), cB, voffB); PG8_STAGE(PG8_SB(0, 1), cB + hstepB, voffB); PG8_STAGE(PG8_SA(0, 0), cA, voffA); PG8_STAGE(PG8_SA(0, 1), cA + hstepA, voffA);
    if (wr == 1) PG8_BAR;
    PG8_WAIT_V(2); PG8_BAR;
    PG8_STAGE(PG8_SB(1, 0), cB + kstep, voffB); PG8_STAGE(PG8_SA(1, 0), cA + kstep, voffA); PG8_STAGE(PG8_SB(1, 1), cB + hstepB + kstep, voffB);
    PG8_WAIT_V(6); PG8_BAR;
    for (;;) {
        const bool has_next = S.next(ui + 1, nxt);
        const char* nA = has_next ? (const char*)g.A + (size_t)nxt.pm * g.a_pm_stride + (size_t)nxt.pn * pnoffA : cA; const char* nB = has_next ? (const char*)g.Bt + (size_t)nxt.pn * tstepB + (size_t)nxt.pm * g.b_pm_stride : cB;
        for (int t = 0; t < nt; t += 2) {
            const bool last = (t == nt - 2);
            const char* a1 = cA + (size_t)(t + 1) * kstep;
            const char* a2 = last ? nA : cA + (size_t)(t + 2) * kstep; const char* b2 = last ? nB : cB + (size_t)(t + 2) * kstep;
            const char* a3 = a2 + kstep; const char* b3 = b2 + kstep;
            if (last && has_next) S.a_ready(nxt);
            if (last) { pre = E.pre(cur, wr, wc, fr, fq); PG8_SCHED; }
            PG8_LDB(B0, 0, 0); PG8_LDB(B1, 0, 1); PG8_SCHED; PG8_LDA(At, 0, 0); PG8_STAGE(PG8_SA(1, 1), a1 + hstepA, voffA);
            PG8_WAIT_V(8); PG8_WAIT_L(0); PG8_BAR; PG8_MMA(0, 0, At, B0); PG8_MMA(0, 1, At, B1); PG8_BAR; PG8_SCHED;
            PG8_LDA(At, 0, 1); PG8_STAGE(PG8_SB(0, 0), b2, voffB); PG8_STAGE(PG8_SB(0, 1), b2 + hstepB, voffB); PG8_STAGE(PG8_SA(0, 0), a2, voffA);
            PG8_WAIT_V(8); PG8_WAIT_L(0); PG8_BAR; PG8_MMA(1, 0, At, B0); PG8_MMA(1, 1, At, B1); PG8_BAR; PG8_SCHED;
            PG8_LDB(B0, 1, 0); PG8_LDB(B1, 1, 1); PG8_SCHED; PG8_LDA(At, 1, 0); PG8_STAGE(PG8_SA(0, 1), a2 + hstepA, voffA);
            PG8_WAIT_V(8); PG8_WAIT_L(0); PG8_BAR; PG8_MMA(0, 0, At, B0); PG8_MMA(0, 1, At, B1); PG8_BAR; PG8_SCHED;
            PG8_LDA(At, 1, 1); PG8_STAGE(PG8_SB(1, 0), b3, voffB); PG8_STAGE(PG8_SB(1, 1), b3 + hstepB, voffB); PG8_STAGE(PG8_SA(1, 0), a3, voffA);
            PG8_WAIT_V(8); PG8_WAIT_L(0); PG8_BAR; PG8_MMA(1, 0, At, B0); PG8_MMA(1, 1, At, B1); PG8_BAR; PG8_SCHED;
        }
        if (wr == 0) PG8_BAR;
        { Unit eu; eu.pm = __builtin_amdgcn_readfirstlane(cur.pm); eu.pn = __builtin_amdgcn_readfirstlane(cur.pn); eu.job = 0; asm volatile("" : "+s"(eu.pm), "+s"(eu.pn));
          int efr = fr; asm volatile("" : "+v"(efr));
          E(acc, eu, wr, wc, efr, fq, pre); }
        S.done(cur);
        if (!has_next) break;
#pragma unroll
        for (int a = 0; a < 2; ++a)
#pragma unroll
            for (int b = 0; b < 2; ++b)
#pragma unroll
                for (int m = 0; m < 4; ++m)
#pragma unroll
                    for (int n = 0; n < 2; ++n) acc[a][b][m][n] = (f32x4){0.f, 0.f, 0.f, 0.f};
        cur = nxt; cA = nA; cB = nB; ++ui;
        if (wr == 1) PG8_BAR;
    }
    PG8_WAIT_V(0);
    PG8_BAR;
#undef PG8_SA
#undef PG8_SB
#undef PG8_STAGE
#undef PG8_LDA
#undef PG8_LDB
#undef PG8_MMA
#undef PG8_WAIT_V
#undef PG8_WAIT_L
#undef PG8_BAR
#undef PG8_SCHED
}
template <class Epi, class Sched>
__device__ __forceinline__ void gemm_phase3(LAS unsigned char* lds, const Gemm (&gj)[3], const Sched& S, const Epi& E, const int tid) {
    const int wid = __builtin_amdgcn_readfirstlane(tid >> 6), lane = tid & 63, wr = wid >> 2, wc = wid & 3, fr = lane & 15, fq = lane >> 4;
    int sR[2], sRb[2], sC[2];
#pragma unroll
    for (int i = 0; i < 2; ++i) { stage_rc(tid * 16 + i * 8192, sR[i], sC[i]); sRb[i] = Epi::PERM ? ((sR[i] & ~31) + perm32(sR[i] & 31)) : sR[i]; }
    const size_t kstep = (size_t)(BK * 2);
    int nt; unsigned voffA[2], voffB[2], nvoffA[2], nvoffB[2]; size_t hstepA, hstepB, nhstepA, nhstepB;
#define PG8_JOBPARAMS(J, VA, VB, HA, HB) do { _Pragma("unroll") for (int _i = 0; _i < 2; ++_i) { VA[_i] = (unsigned)(sR[_i] * gj[J].lda + sC[_i]) * 2u; VB[_i] = (unsigned)(sRb[_i] * gj[J].ldb + sC[_i]) * 2u; } \
        HA = (size_t)HALF * gj[J].lda * 2; HB = (size_t)HALF * gj[J].ldb * 2; } while (0)
#define PG8_ABASE(J, U) ((const char*)gj[J].A + (size_t)(U).pm * gj[J].a_pm_stride + (size_t)(U).pn * ((size_t)gj[J].a_pn_off * 2))
#define PG8_BBASE(J, U) ((const char*)gj[J].Bt + (size_t)(U).pn * ((size_t)BM * gj[J].ldb * 2) + (size_t)(U).pm * gj[J].b_pm_stride)
    const unsigned ldsw = (unsigned)wid * 1024u;
    const int aoff = lds_byte(wr * 64 + fr, fq * 8), boff = lds_byte(wc * 32 + fr, fq * 8);
#define PG8_SA(b, h) (((b) * 2 + (h)) * HTB)
#define PG8_SB(b, h) ((4 + (b) * 2 + (h)) * HTB)
#define PG8_STAGE(bufoff, gbase, voff) do { _Pragma("unroll") for (int _i = 0; _i < 2; ++_i) \
        __builtin_amdgcn_global_load_lds((const GAS unsigned*)((const char*)(gbase) + (voff)[_i]), (LAS unsigned*)(lds + (bufoff) + ldsw + _i * 8192), 16, 0, 0); } while (0)
#define PG8_LDA(dst, b, h) do { _Pragma("unroll") for (int m = 0; m < 4; ++m) _Pragma("unroll") for (int k = 0; k < 2; ++k) dst[m][k] = *(const LAS bf16x8*)(lds + PG8_SA(b, h) + aoff + m * 2048 + k * 1024); } while (0)
#define PG8_LDB(dst, b, h) do { _Pragma("unroll") for (int n = 0; n < 2; ++n) _Pragma("unroll") for (int k = 0; k < 2; ++k) dst[n][k] = *(const LAS bf16x8*)(lds + PG8_SB(b, h) + boff + n * 2048 + k * 1024); } while (0)
#define PG8_MMA(ai, bj, At, Bt) do { __builtin_amdgcn_s_setprio(1); _Pragma("unroll") for (int m = 0; m < 4; ++m) _Pragma("unroll") for (int n = 0; n < 2; ++n) _Pragma("unroll") for (int k = 0; k < 2; ++k) \
        acc[ai][bj][m][n] = __builtin_amdgcn_mfma_f32_16x16x32_bf16(Bt[n][k], At[m][k], acc[ai][bj][m][n], 0, 0, 0); __builtin_amdgcn_s_setprio(0); } while (0)
#define PG8_WAIT_V(n) asm volatile("s_waitcnt vmcnt(" #n ")" ::: "memory")
#define PG8_WAIT_L(n) asm volatile("s_waitcnt lgkmcnt(" #n ")" ::: "memory")
#define PG8_BAR __builtin_amdgcn_s_barrier()
#define PG8_SCHED __builtin_amdgcn_sched_barrier(0)
    Unit cur, nxt; int ui = 0;
    if (!S.next(0, cur)) return;
    cur.job = 0; PG8_JOBPARAMS(0, voffA, voffB, hstepA, hstepB); nt = gj[0].K / BK;
    f32x4 acc[2][2][4][2];
#pragma unroll
    for (int a = 0; a < 2; ++a)
#pragma unroll
        for (int b = 0; b < 2; ++b)
#pragma unroll
            for (int m = 0; m < 4; ++m)
#pragma unroll
                for (int n = 0; n < 2; ++n) acc[a][b][m][n] = (f32x4){0.f, 0.f, 0.f, 0.f};
    bf16x8 At[4][2], B0[2][2], B1[2][2];
    typename Epi::Pre pre = {};
    const char* cA = PG8_ABASE(0, cur); const char* cB = PG8_BBASE(0, cur);
    S.a_ready(cur);
    PG8_STAGE(PG8_SB(0, 0), cB, voffB); PG8_STAGE(PG8_SB(0, 1), cB + hstepB, voffB); PG8_STAGE(PG8_SA(0, 0), cA, voffA); PG8_STAGE(PG8_SA(0, 1), cA + hstepA, voffA);
    if (wr == 1) PG8_BAR;
    PG8_WAIT_V(2); PG8_BAR;
    PG8_STAGE(PG8_SB(1, 0), cB + kstep, voffB); PG8_STAGE(PG8_SA(1, 0), cA + kstep, voffA); PG8_STAGE(PG8_SB(1, 1), cB + hstepB + kstep, voffB);
    PG8_WAIT_V(6); PG8_BAR;
    for (;;) {
        const int nj = (ui + 1) % 3;
        const bool has_next = S.next((ui + 1) / 3, nxt); nxt.job = nj;
        const char* nA = cA; const char* nB = cB;
#pragma unroll
        for (int _i = 0; _i < 2; ++_i) { nvoffA[_i] = voffA[_i]; nvoffB[_i] = voffB[_i]; } nhstepA = hstepA; nhstepB = hstepB;
        if (has_next) { if (nj == 0) { PG8_JOBPARAMS(0, nvoffA, nvoffB, nhstepA, nhstepB); nA = PG8_ABASE(0, nxt); nB = PG8_BBASE(0, nxt); }
                        else if (nj == 1) { PG8_JOBPARAMS(1, nvoffA, nvoffB, nhstepA, nhstepB); nA = PG8_ABASE(1, nxt); nB = PG8_BBASE(1, nxt); }
                        else { PG8_JOBPARAMS(2, nvoffA, nvoffB, nhstepA, nhstepB); nA = PG8_ABASE(2, nxt); nB = PG8_BBASE(2, nxt); } }
        for (int t = 0; t < nt; t += 2) {
            const bool last = (t == nt - 2);
            const char* a1 = cA + (size_t)(t + 1) * kstep;
            const char* a2 = last ? nA : cA + (size_t)(t + 2) * kstep; const char* b2 = last ? nB : cB + (size_t)(t + 2) * kstep;
            const char* a3 = a2 + kstep; const char* b3 = b2 + kstep;
            unsigned vA2[2], vB2[2]; vA2[0] = last ? nvoffA[0] : voffA[0]; vA2[1] = last ? nvoffA[1] : voffA[1]; vB2[0] = last ? nvoffB[0] : voffB[0]; vB2[1] = last ? nvoffB[1] : voffB[1];
            const size_t hA2 = last ? nhstepA : hstepA, hB2 = last ? nhstepB : hstepB;
            if (last && has_next) S.a_ready(nxt);
            if (last) { pre = E.pre(cur, wr, wc, fr, fq); PG8_SCHED; }
            PG8_LDB(B0, 0, 0); PG8_LDB(B1, 0, 1); PG8_SCHED; PG8_LDA(At, 0, 0); PG8_STAGE(PG8_SA(1, 1), a1 + hstepA, voffA);
            PG8_WAIT_V(8); PG8_WAIT_L(0); PG8_BAR; PG8_MMA(0, 0, At, B0); PG8_MMA(0, 1, At, B1); PG8_BAR; PG8_SCHED;
            PG8_LDA(At, 0, 1); PG8_STAGE(PG8_SB(0, 0), b2, vB2); PG8_STAGE(PG8_SB(0, 1), b2 + hB2, vB2); PG8_STAGE(PG8_SA(0, 0), a2, vA2);
            PG8_WAIT_V(8); PG8_WAIT_L(0); PG8_BAR; PG8_MMA(1, 0, At, B0); PG8_MMA(1, 1, At, B1); PG8_BAR; PG8_SCHED;
            PG8_LDB(B0, 1, 0); PG8_LDB(B1, 1, 1); PG8_SCHED; PG8_LDA(At, 1, 0); PG8_STAGE(PG8_SA(0, 1), a2 + hA2, vA2);
            PG8_WAIT_V(8); PG8_WAIT_L(0); PG8_BAR; PG8_MMA(0, 0, At, B0); PG8_MMA(0, 1, At, B1); PG8_BAR; PG8_SCHED;
            PG8_LDA(At, 1, 1); PG8_STAGE(PG8_SB(1, 0), b3, vB2); PG8_STAGE(PG8_SB(1, 1), b3 + hB2, vB2); PG8_STAGE(PG8_SA(1, 0), a3, vA2);
            PG8_WAIT_V(8); PG8_WAIT_L(0); PG8_BAR; PG8_MMA(1, 0, At, B0); PG8_MMA(1, 1, At, B1); PG8_BAR; PG8_SCHED;
        }
        if (wr == 0) PG8_BAR;
        { Unit eu; eu.pm = __builtin_amdgcn_readfirstlane(cur.pm); eu.pn = __builtin_amdgcn_readfirstlane(cur.pn); eu.job = __builtin_amdgcn_readfirstlane(cur.job); asm volatile("" : "+s"(eu.pm), "+s"(eu.pn));
          int efr = fr; asm volatile("" : "+v"(efr));
          E(acc, eu, wr, wc, efr, fq, pre); }
        S.done(cur);
        if (!has_next) break;
        if (nxt.job == 0)
#pragma unroll
        for (int a = 0; a < 2; ++a)
#pragma unroll
            for (int b = 0; b < 2; ++b)
#pragma unroll
                for (int m = 0; m < 4; ++m)
#pragma unroll
                    for (int n = 0; n < 2; ++n) acc[a][b][m][n] = (f32x4){0.f, 0.f, 0.f, 0.f};
        cur = nxt; cA = nA; cB = nB; ++ui;
#pragma unroll
        for (int _i = 0; _i < 2; ++_i) { voffA[_i] = nvoffA[_i]; voffB[_i] = nvoffB[_i]; } hstepA = nhstepA; hstepB = nhstepB; nt = gj[0].K / BK; if (cur.job == 1) nt = gj[1].K / BK; if (cur.job == 2) nt = gj[2].K / BK;
        if (wr == 1) PG8_BAR;
    }
    PG8_WAIT_V(0);
    PG8_BAR;
#undef PG8_JOBPARAMS
#undef PG8_ABASE
#undef PG8_BBASE
#undef PG8_SA
#undef PG8_SB
#undef PG8_STAGE
#undef PG8_LDA
#undef PG8_LDB
#undef PG8_MMA
#undef PG8_WAIT_V
#undef PG8_WAIT_L
#undef PG8_BAR
#undef PG8_SCHED
}
}

typedef unsigned ssq_t;
constexpr float SSQ_SCALE = 4096.0f, SSQ_INV = 1.0f / 4096.0f;
__device__ __forceinline__ float row_rstd(const ssq_t* ssq, int r) { return __builtin_amdgcn_rsqf((float)*(const GAS ssq_t*)(ssq + r) * (SSQ_INV / D) + EPS); }
struct EpiAda {
    static constexpr bool PERM = false;
    float* mod; const float* bias; const float* normg; bf16_t* sh;
    struct Pre {}; __device__ __forceinline__ Pre pre(const pg8::Unit&, int, int, int, int) const { return Pre{}; }
    __device__ __forceinline__ void operator()(const f32x4 (&acc)[2][2][4][2], const pg8::Unit& u, int wr, int wc, int fr, int fq, const Pre&) const {
        const int row0 = wr * 64 + fr, col0 = u.pn * 256 + wc * 32 + 4 * fq;
        const int l = (u.pn * 256) / NADA, rem = u.pn * 256 - l * NADA, sub3 = rem >> 10, which = sub3 % 3, sub = sub3 / 3, d0 = (rem & 1023) + wc * 32 + 4 * fq;
#pragma unroll
        for (int ai = 0; ai < 2; ++ai)
#pragma unroll
            for (int m = 0; m < 4; ++m) { const int r = row0 + ai * 128 + m * 16;
                if (r < NBATCH) {
#pragma unroll
                    for (int bj = 0; bj < 2; ++bj)
#pragma unroll
                        for (int n = 0; n < 2; ++n) { const int o = bj * 128 + n * 16; f32x4 v = acc[ai][bj][m][n] + *(const GAS f32x4*)(bias + col0 + o);
                            if (which == 0) { u32x2 w; w.x = cvt_pk_bf16(v[0], v[1]); w.y = cvt_pk_bf16(v[2], v[3]); *(GAS u32x2*)(sh + ((size_t)(l * 3 + sub) * 256 + r) * D + d0 + o) = w; }
                            else { if (which == 1) v = *(const GAS f32x4*)(normg + (l * 3 + sub) * D + d0 + o) * (v + 1.0f);
                                *(GAS f32x4*)(mod + (size_t)r * 36864 + col0 + o) = v; } } } }
    }
};
struct EpiSB {
    static constexpr bool PERM = false;
    float* sb; int off;
    struct Pre {}; __device__ __forceinline__ Pre pre(const pg8::Unit&, int, int, int, int) const { return Pre{}; }
    __device__ __forceinline__ void operator()(const f32x4 (&acc)[2][2][4][2], const pg8::Unit& u, int wr, int wc, int fr, int fq, const Pre&) const {
        const int row0 = wr * 64 + fr, col0 = u.pm * SB_LAYER + off + u.pn * 256 + wc * 32 + 4 * fq;
#pragma unroll
        for (int ai = 0; ai < 2; ++ai)
#pragma unroll
            for (int m = 0; m < 4; ++m) { const int r = row0 + ai * 128 + m * 16;
                if (r < NBATCH) {
#pragma unroll
                    for (int bj = 0; bj < 2; ++bj)
#pragma unroll
                        for (int n = 0; n < 2; ++n) *(GAS f32x4*)(sb + (size_t)r * SB_LD + col0 + bj * 128 + n * 16) = acc[ai][bj][m][n]; } }
    }
};
struct EpiSwiglu {
    static constexpr bool PERM = true;
    bf16_t* G; bf16_t* GSv; const ssq_t* ssq; const float* sb;
    struct Pre { ssq_t rs[8]; f32x4 sa[2], sbb[2]; };
    __device__ __forceinline__ Pre pre(const pg8::Unit& u, int wr, int wc, int fr, int fq) const {
        Pre p; const int row0 = u.pm * 256 + wr * 64 + fr, scol = u.pn * 256 + wc * 32 + 8 * fq;
#pragma unroll
        for (int i = 0; i < 8; ++i) p.rs[i] = *(const GAS ssq_t*)(ssq + row0 + (i >> 2) * 128 + (i & 3) * 16);
        const float* sp = sb + (size_t)(u.pm < 64 ? (u.pm >> 3) : 0) * SB_LD + scol;
#pragma unroll
        for (int n = 0; n < 2; ++n) { p.sa[n] = *(const GAS f32x4*)(sp + 4 * n); p.sbb[n] = *(const GAS f32x4*)(sp + 128 + 4 * n); }
        return p;
    }
    __device__ __forceinline__ void operator()(const f32x4 (&acc)[2][2][4][2], const pg8::Unit& u, int wr, int wc, int fr, int fq, const Pre& p) const {
        const int row0 = u.pm * 256 + wr * 64 + fr, col0 = u.pn * 128 + wc * 32 + 8 * fq, scol = u.pn * 256 + wc * 32 + 8 * fq;
        const bool uni = u.pm < 64;
        bf16_t* Gb = sel_ptr(uni, G, GSv);
        float rs[8];
#pragma unroll
        for (int i = 0; i < 8; ++i) rs[i] = (float)p.rs[i] * SSQ_INV;
        f32x4 sa[2], sbb[2];
#pragma unroll
        for (int n = 0; n < 2; ++n) { sa[n] = p.sa[n]; sbb[n] = p.sbb[n]; }
#pragma unroll
        for (int am = 0; am < 4; ++am) { const int ai = am >> 1, m0 = (am & 1) * 2;
            f32x4 ra[4][2], rb[4][2];
            if (!uni) {
#pragma unroll
                for (int m = m0; m < m0 + 2; ++m) { const float* sp = sb + (size_t)row_batch(row0 + ai * 128 + m * 16) * SB_LD + scol;
#pragma unroll
                    for (int n = 0; n < 2; ++n) { ra[m][n] = *(const GAS f32x4*)(sp + 4 * n); rb[m][n] = *(const GAS f32x4*)(sp + 128 + 4 * n); } } }
#pragma unroll
            for (int m = m0; m < m0 + 2; ++m) { const int i = ai * 4 + m, r = row0 + ai * 128 + m * 16; const float rr = __builtin_amdgcn_rsqf(rs[i] * (1.f / D) + EPS); float v[8];
                if (!uni) {
#pragma unroll
                    for (int n = 0; n < 2; ++n) { sa[n] = ra[m][n]; sbb[n] = rb[m][n]; } }
#pragma unroll
                for (int n = 0; n < 2; ++n)
#pragma unroll
                    for (int j = 0; j < 4; ++j) v[n * 4 + j] = fast_silu(acc[ai][0][m][n][j] * rr + sa[n][j]) * (acc[ai][1][m][n][j] * rr + sbb[n][j]);
                *(GAS u32x4*)(Gb + (size_t)r * DFF + col0) = pack8(v); } }
    }
};
struct EpiResid {
    static constexpr bool PERM = true;
    const float* gate0; const float* gsc0; const float* gsn0; bf16_t* H; ssq_t* ssq; float s; int fin;
    struct Pre {}; __device__ __forceinline__ Pre pre(const pg8::Unit&, int, int, int, int) const { return Pre{}; }
    __device__ __forceinline__ void operator()(const f32x4 (&acc)[2][2][4][2], const pg8::Unit& u, int wr, int wc, int fr, int fq, const Pre&) const {
        const int row0 = u.pm * 256 + wr * 64 + fr, col0 = u.pn * 256 + wc * 32 + 8 * fq, ln = fr + 16 * fq;
        const bool uni = u.pm < 64;
        f32x4 g[2][2], hs[2][2], rc[2][2];
#define ER_LOAD(bo) do { _Pragma("unroll") for (int bj = 0; bj < 2; ++bj) _Pragma("unroll") for (int n = 0; n < 2; ++n) { const size_t o = (bo) + bj * 128 + n * 4; g[bj][n] = *(const GAS f32x4*)(gate0 + o) * s; \
            const f32x4 c = *(const GAS f32x4*)(gsc0 + o); rc[bj][n] = (f32x4){__builtin_amdgcn_rcpf(c[0]), __builtin_amdgcn_rcpf(c[1]), __builtin_amdgcn_rcpf(c[2]), __builtin_amdgcn_rcpf(c[3])}; \
            hs[bj][n] = fin ? (f32x4){1.f, 1.f, 1.f, 1.f} : *(const GAS f32x4*)(gsn0 + o); } } while (0)
        if (uni) ER_LOAD((size_t)(u.pm >> 3) * 36864 + col0);
#pragma unroll
        for (int am = 0; am < 4; ++am) { const int ai = am >> 1, m0 = (am & 1) * 2;
            u32x4 xr[4][2];
#pragma unroll
            for (int m = m0; m < m0 + 2; ++m)
#pragma unroll
                for (int bj = 0; bj < 2; ++bj) xr[m][bj] = *(const GAS u32x4*)(H + (size_t)(row0 + ai * 128 + m * 16) * D + col0 + bj * 128);
#pragma unroll
            for (int m = m0; m < m0 + 2; ++m) { const int r = row0 + ai * 128 + m * 16; float q = 0.f;
                if (!uni) ER_LOAD((size_t)row_batch(r) * 36864 + col0);
#pragma unroll
                for (int bj = 0; bj < 2; ++bj) { float x[8]; unpack8(xr[m][bj], x);
#pragma unroll
                    for (int n = 0; n < 2; ++n)
#pragma unroll
                        for (int j = 0; j < 4; ++j) { const float v = x[n * 4 + j] * rc[bj][n][j] + g[bj][n][j] * acc[ai][bj][m][n][j]; q += v * v; x[n * 4 + j] = v * hs[bj][n][j]; }
                    *(GAS u32x4*)(H + (size_t)r * D + col0 + bj * 128) = pack8(x); }
                q += __int_as_float(__builtin_amdgcn_ds_bpermute((ln ^ 16) << 2, __float_as_int(q))); q += __int_as_float(__builtin_amdgcn_ds_bpermute((ln ^ 32) << 2, __float_as_int(q)));
                if (fq == 0) (void)__hip_atomic_fetch_add(ssq + r, (ssq_t)(q * SSQ_SCALE + 0.5f), __ATOMIC_RELAXED, __HIP_MEMORY_SCOPE_AGENT); } }
#undef ER_LOAD
    }
};
struct EpiProj {
    static constexpr bool PERM = true;
    bf16_t* PA; bf16_t* PG; const ssq_t* ssq; const float* sb;
    struct Pre { ssq_t rs[8]; f32x4 sv[2][2]; };
    __device__ __forceinline__ Pre pre(const pg8::Unit& u, int wr, int wc, int fr, int fq) const {
        Pre p; const int row0 = u.pm * 256 + wr * 64 + fr, scol = u.pn * 256 + wc * 32 + 8 * fq;
#pragma unroll
        for (int i = 0; i < 8; ++i) p.rs[i] = *(const GAS ssq_t*)(ssq + row0 + (i >> 2) * 128 + (i & 3) * 16);
        const float* sp = sb + (size_t)(u.pm < 64 ? (u.pm >> 3) : 0) * SB_LD + scol;
#pragma unroll
        for (int bj = 0; bj < 2; ++bj)
#pragma unroll
            for (int n = 0; n < 2; ++n) p.sv[bj][n] = *(const GAS f32x4*)(sp + bj * 128 + 4 * n);
        return p;
    }
    __device__ __forceinline__ void operator()(const f32x4 (&acc)[2][2][4][2], const pg8::Unit& u, int wr, int wc, int fr, int fq, const Pre& p) const {
        const int row0 = u.pm * 256 + wr * 64 + fr, scol = u.pn * 256 + wc * 32 + 8 * fq;
        const int act = (u.pn >= 12) ? 2 : ((u.pn >= 6 && u.pn < 10) ? 1 : 0);
        bf16_t* P = u.pn >= 12 ? PG + (u.pn - 12) * 256 + wc * 32 + 8 * fq : PA + scol;
        const bool uni = u.pm < 64;
        float rs[8];
#pragma unroll
        for (int i = 0; i < 8; ++i) rs[i] = (float)p.rs[i] * SSQ_INV;
        f32x4 sv[2][2];
#pragma unroll
        for (int bj = 0; bj < 2; ++bj)
#pragma unroll
            for (int n = 0; n < 2; ++n) sv[bj][n] = p.sv[bj][n];
#pragma unroll
        for (int am = 0; am < 4; ++am) { const int ai = am >> 1, m0 = (am & 1) * 2;
            f32x4 rv[4][2][2];
            if (!uni) {
#pragma unroll
                for (int m = m0; m < m0 + 2; ++m) { const float* sp = sb + (size_t)row_batch(row0 + ai * 128 + m * 16) * SB_LD + scol;
#pragma unroll
                    for (int bj = 0; bj < 2; ++bj)
#pragma unroll
                        for (int n = 0; n < 2; ++n) rv[m][bj][n] = *(const GAS f32x4*)(sp + bj * 128 + 4 * n); } }
#pragma unroll
            for (int m = m0; m < m0 + 2; ++m) { const int i = ai * 4 + m, r = row0 + ai * 128 + m * 16; const float rr = __builtin_amdgcn_rsqf(rs[i] * (1.f / D) + EPS); bf16_t* rowp = P + (size_t)r * 3072;
                if (!uni) {
#pragma unroll
                    for (int bj = 0; bj < 2; ++bj)
#pragma unroll
                        for (int n = 0; n < 2; ++n) sv[bj][n] = rv[m][bj][n]; }
#pragma unroll
                for (int bj = 0; bj < 2; ++bj) { float v[8];
#pragma unroll
                    for (int n = 0; n < 2; ++n)
#pragma unroll
                        for (int j = 0; j < 4; ++j) v[n * 4 + j] = acc[ai][bj][m][n][j] * rr + sv[bj][n][j];
                    if (act == 1) {
#pragma unroll
                        for (int q = 0; q < 4; ++q) { const f32x2 o = gelu_pk((f32x2){v[2 * q], v[2 * q + 1]}); v[2 * q] = o.x; v[2 * q + 1] = o.y; } }
                    else if (act == 2) {
#pragma unroll
                        for (int q = 0; q < 8; ++q) v[q] = fast_sigmoid(v[q]); }
                    *(GAS u32x4*)(rowp + bj * 128) = pack8(v); } } }
    }
};
struct EpiMix {
    static constexpr bool PERM = true;
    bf16_t* MgP; bf16_t* MgSv; const bf16_t* sg0; const float* ps0;
    struct Pre {}; __device__ __forceinline__ Pre pre(const pg8::Unit&, int, int, int, int) const { return Pre{}; }
    __device__ __forceinline__ void operator()(f32x4 (&acc)[2][2][4][2], const pg8::Unit& u, int wr, int wc, int fr, int fq, const Pre&) const {
        const int row0 = u.pm * 256 + wr * 64 + fr, col0 = u.pn * 256 + wc * 32 + 8 * fq, job = u.job;
        bf16_t* Mg = sel_ptr(u.pm < 64, MgP, MgSv);
        const bf16_t* gN = sg0 + (job == 0 ? 0 : (job == 1 ? 1024 : 2048));
        const bf16_t* gD = sg0 + (job == 0 ? 1024 : 2048);
        float sc[2][8];
#pragma unroll
        for (int bj = 0; bj < 2; ++bj) { const int c = col0 + bj * 128; const f32x4 p0 = *(const GAS f32x4*)(ps0 + c), p1 = *(const GAS f32x4*)(ps0 + c + 4);
            sc[bj][0] = p0[0]; sc[bj][1] = p0[1]; sc[bj][2] = p0[2]; sc[bj][3] = p0[3]; sc[bj][4] = p1[0]; sc[bj][5] = p1[1]; sc[bj][6] = p1[2]; sc[bj][7] = p1[3]; }
#pragma unroll
        for (int am = 0; am < 4; ++am) { const int ai = am >> 1, m0 = (am & 1) * 2;
            u32x4 nr[4][2], dr[4][2];
#pragma unroll
            for (int m = m0; m < m0 + 2; ++m)
#pragma unroll
                for (int bj = 0; bj < 2; ++bj) { const size_t r = (size_t)(row0 + ai * 128 + m * 16); nr[m][bj] = *(const GAS u32x4*)(gN + r * 3072 + col0 + bj * 128);
                    dr[m][bj] = job < 2 ? *(const GAS u32x4*)(gD + r * 3072 + col0 + bj * 128) : (u32x4){0u, 0u, 0u, 0u}; }
#pragma unroll
            for (int m = m0; m < m0 + 2; ++m) { const size_t r = (size_t)(row0 + ai * 128 + m * 16);
#pragma unroll
                for (int bj = 0; bj < 2; ++bj) { float n8[8], d8[8]; unpack8(nr[m][bj], n8); unpack8(dr[m][bj], d8);
                    if (job == 2) { float v[8];
#pragma unroll
                        for (int n = 0; n < 2; ++n)
#pragma unroll
                            for (int j = 0; j < 4; ++j) v[n * 4 + j] = acc[ai][bj][m][n][j] * n8[n * 4 + j] * sc[bj][n * 4 + j];
                        *(GAS u32x4*)(Mg + r * D + col0 + bj * 128) = pack8(v); }
                    else {
#pragma unroll
                        for (int n = 0; n < 2; ++n)
#pragma unroll
                            for (int j = 0; j < 4; ++j) { const float den = fmaxf(job == 0 ? d8[n * 4 + j] : d8[n * 4 + j] * sc[bj][n * 4 + j] * (sc[bj][n * 4 + j] < 0.f ? -1.f : 1.f), 1e-30f) * (job == 1 && sc[bj][n * 4 + j] < 0.f ? -1.f : 1.f);
                                acc[ai][bj][m][n][j] *= n8[n * 4 + j] * __builtin_amdgcn_rcpf(den); } } } } }
    }
};

#define XB_TMO      128
#define XB_XCNT(j)  (256  + 64 * (j))
#define XB_XSUB(j)  (1280 + 64 * (j))
#define XB_XGEN(j)  (2304 + 64 * (j))
#define XB_TOP      3328
#define XB_TOPGEN   3392
#define XCD_BAR_WORDS 3456
#define XB_SPIN_CAP (1u << 22)
__device__ __forceinline__ unsigned xb_ld(unsigned* p)              { return __hip_atomic_load(p, __ATOMIC_RELAXED, __HIP_MEMORY_SCOPE_AGENT); }
__device__ __forceinline__ unsigned xb_add(unsigned* p, unsigned v) { return __hip_atomic_fetch_add(p, v, __ATOMIC_RELAXED, __HIP_MEMORY_SCOPE_AGENT); }
__device__ __forceinline__ unsigned xb_xcc_id() { return (unsigned)__builtin_amdgcn_s_getreg((3 << 11) | 20) & 0xFu; }
#define XB_SPIN(cond, bar) do { unsigned _sp = 0; while (cond) { __builtin_amdgcn_s_sleep(1); \
    if ((++_sp & 255u) == 0u) { if (xb_ld(&(bar)[XB_TMO])) break; if (_sp > XB_SPIN_CAP) { atomicAdd(&(bar)[XB_TMO], 1u); break; } } } } while (0)
struct XcdBarrier { unsigned* bar; unsigned x; volatile LAS unsigned* st; };
__device__ __forceinline__ XcdBarrier xcd_barrier_post(unsigned* bar, volatile LAS unsigned* st) {
    XcdBarrier b; b.bar = bar; b.x = xb_xcc_id(); b.st = st;
    if (threadIdx.x == 0) (void)xb_add(&bar[XB_XCNT(b.x)], 1u);
    return b;
}
__device__ __forceinline__ void xcd_barrier_complete(unsigned* bar, unsigned x, unsigned& nloc, unsigned& nx) {
    const unsigned G = gridDim.x * gridDim.y * gridDim.z;
    unsigned sum, cnt, mine, sp = 0u;
    for (;;) {
        sum = 0u; cnt = 0u; mine = 0u;
#pragma unroll
        for (unsigned j = 0; j < 16; ++j) { const unsigned c = xb_ld(&bar[XB_XCNT(j)]); sum += c; cnt += (c > 0u) ? 1u : 0u; mine = (j == x) ? c : mine; }
        if (sum == G) break;
        __builtin_amdgcn_s_sleep(1);
        if ((++sp & 255u) == 0u) { if (xb_ld(&bar[XB_TMO])) break; if (sp > XB_SPIN_CAP) { atomicAdd(&bar[XB_TMO], 1u); break; } }
    }
    nloc = mine > 0u ? mine : 1u; nx = cnt > 0u ? cnt : 1u;
}
__device__ __forceinline__ void xcd_barrier(const XcdBarrier& b) {
    asm volatile("s_waitcnt vmcnt(0)" ::: "memory");
    __syncthreads();
    if (threadIdx.x == 0) {
        unsigned* bar = b.bar;
        __builtin_amdgcn_s_waitcnt(0);
        unsigned nloc = b.st[0], nx = b.st[1];
        if (nloc == 0u) { xcd_barrier_complete(bar, b.x, nloc, nx); b.st[0] = nloc; b.st[1] = nx; }
        const unsigned old = xb_add(&bar[XB_XSUB(b.x)], 1u);
        const unsigned gen = old / nloc;
        if (old + 1u == (gen + 1u) * nloc) {
            __builtin_amdgcn_fence(__ATOMIC_RELEASE, "agent");
            asm volatile("s_waitcnt vmcnt(0)" ::: "memory");
            const unsigned og = xb_add(&bar[XB_TOP], 1u);
            const unsigned tg = og / nx;
            if (og + 1u == (tg + 1u) * nx) xb_add(&bar[XB_TOPGEN], 1u);
            else XB_SPIN(xb_ld(&bar[XB_TOPGEN]) == tg, bar);
            __builtin_amdgcn_fence(__ATOMIC_ACQUIRE, "agent");
            xb_add(&bar[XB_XGEN(b.x)], 1u);
            asm volatile("s_waitcnt vmcnt(0)" ::: "memory");
        } else {
            XB_SPIN(xb_ld(&bar[XB_XGEN(b.x)]) == gen, bar);
            __builtin_amdgcn_fence(__ATOMIC_ACQUIRE, "agent");
            asm volatile("s_waitcnt vmcnt(0)" ::: "memory");
        }
    }
    __syncthreads();
}

__device__ __forceinline__ int opaque_lane() { int l; asm volatile("v_mbcnt_lo_u32_b32 %0, -1, 0\n\tv_mbcnt_hi_u32_b32 %0, -1, %0" : "=v"(l)); return l; }
__device__ __forceinline__ void dep_signal(unsigned* cnt, bool leader) {
    if (leader) { __builtin_amdgcn_fence(__ATOMIC_RELEASE, "agent"); asm volatile("s_waitcnt vmcnt(0)" ::: "memory"); (void)xb_add(cnt, 1u); }
}
__device__ __forceinline__ void dep_wait(unsigned* cnt, unsigned need, bool leader) {
    if (leader) { unsigned sp = 0; while (xb_ld(cnt) < need) { __builtin_amdgcn_s_sleep(2); if (++sp > (1u << 22)) break; }
        __builtin_amdgcn_fence(__ATOMIC_ACQUIRE, "agent"); asm volatile("s_waitcnt vmcnt(0)" ::: "memory"); }
    __syncthreads();
}
struct Args { const float* in[24]; float* out; unsigned char* ws; int ph_lo, ph_hi; };
typedef const __attribute__((address_space(4))) Args* ArgsP;
enum { I_XP = 0, I_XS, I_SCONV, I_SPOOL, I_CP, I_CS, I_NORMG, I_WADA, I_BADA, I_W1GU, I_W1DN, I_W2GU, I_W2DN, I_WIN, I_CONVW, I_WOA, I_LNG, I_WS, I_BS, I_WOB, I_POOLW, I_POOLS, I_WO, I_FNG };
constexpr int NPH = 3 + 8 * DEPTH + 1;

__device__ __forceinline__ void conv_item(const float* W, int K, int N, bf16_t* WT, int ldk, int mode, int rowoff, LAS float* scr, int item, int lane) {
    const int nblk = N / 32, kb = item / nblk, nb = item % nblk, k0 = 64 * kb, n0 = 32 * nb;
    const GAS float* rowp = (const GAS float*)W + (size_t)k0 * N + n0;
    const unsigned loff = (unsigned)((lane >> 5) * N + (lane & 31));
    float tv[32];
#pragma unroll
    for (int i = 0; i < 32; ++i) tv[i] = (rowp + (size_t)(2 * i) * N)[loff];
#pragma unroll
    for (int i = 0; i < 32; ++i) scr[(2 * i + (lane >> 5)) * 33 + (lane & 31)] = tv[i];
    LDS_WAIT();
    const int c = lane & 7;
#pragma unroll
    for (int j = 0; j < 4; ++j) { const int n = (lane >> 3) + 8 * j; const LAS float* s = scr + (8 * c) * 33 + n;
        u32x4 o; o.x = cvt_pk_bf16(s[0 * 33], s[1 * 33]); o.y = cvt_pk_bf16(s[2 * 33], s[3 * 33]); o.z = cvt_pk_bf16(s[4 * 33], s[5 * 33]); o.w = cvt_pk_bf16(s[6 * 33], s[7 * 33]);
        int nn = n0 + n;
        if (mode == 1) { const int half = nn >= DFF ? 1 : 0, jj = nn - half * DFF; nn = (jj >> 7) * 256 + half * 128 + (jj & 127); }
        *(GAS u32x4*)(WT + (size_t)(rowoff + nn) * ldk + k0 + 8 * c) = o; }
    LDS_WAIT();
}
constexpr int IT_GU = 16 * 176, IT_DN = 44 * 32, IT_IN = 16 * 192, IT_OA = 8 * 32, IT_PL = 64, IT_WO = 16 * 32, IT_ADA = 16 * 288;
constexpr int IT_LAYER = 2 * IT_GU + 2 * IT_DN + IT_IN + 2 * IT_OA + IT_PL + IT_WO + IT_ADA;

__device__ __forceinline__ void phase_prologue(ArgsP a, LAS unsigned char* lds, int gw, int NGW, int wave, int lane) {
    unsigned char* ws = a->ws;
    LAS float* scr = (LAS float*)(lds + wave * 16384);
    for (int it = gw; it < DEPTH * IT_LAYER; it += NGW) {
        const int l = it / IT_LAYER; int r = it - l * IT_LAYER;
        bf16_t* LW = (bf16_t*)(ws + WS_W + (size_t)l * LW_SIZE);
        if (r < IT_GU) { conv_item(a->in[I_W1GU] + (size_t)l * 1024 * 5632, 1024, 5632, LW + LW_GU1 / 2, 1024, 1, 0, scr, r, lane); continue; } r -= IT_GU;
        if (r < IT_DN) { conv_item(a->in[I_W1DN] + (size_t)l * 2816 * 1024, 2816, 1024, LW + LW_DN1 / 2, 2816, 0, 0, scr, r, lane); continue; } r -= IT_DN;
        if (r < IT_GU) { conv_item(a->in[I_W2GU] + (size_t)l * 1024 * 5632, 1024, 5632, LW + LW_GU2 / 2, 1024, 1, 0, scr, r, lane); continue; } r -= IT_GU;
        if (r < IT_DN) { conv_item(a->in[I_W2DN] + (size_t)l * 2816 * 1024, 2816, 1024, LW + LW_DN2 / 2, 2816, 0, 0, scr, r, lane); continue; } r -= IT_DN;
        if (r < IT_IN) { conv_item(a->in[I_WIN] + (size_t)l * 1024 * 6144, 1024, 6144, LW + LW_IN / 2, 1024, 0, 0, scr, r, lane); continue; } r -= IT_IN;
        if (r < IT_OA) { conv_item(a->in[I_WOA] + (size_t)l * 512 * 1024, 512, 1024, LW + LW_OA / 2, 512, 0, 0, scr, r, lane); continue; } r -= IT_OA;
        if (r < IT_OA) { conv_item(a->in[I_WOB] + (size_t)l * 512 * 1024, 512, 1024, LW + LW_OB / 2, 512, 0, 0, scr, r, lane); continue; } r -= IT_OA;
        if (r < IT_PL) { const int g = r >> 4; conv_item(a->in[I_POOLW] + (size_t)(l * 4 + g) * 128 * 256, 128, 256, LW + LW_PL / 2, 128, 0, g * 256, scr, r & 15, lane); continue; } r -= IT_PL;
        if (r < IT_WO) { conv_item(a->in[I_WO] + (size_t)l * 1024 * 1024, 1024, 1024, LW + LW_WO / 2, 1024, 0, 0, scr, r, lane); continue; } r -= IT_WO;
        conv_item(a->in[I_WADA] + (size_t)l * 1024 * 9216, 1024, 9216, (bf16_t*)(ws + WS_ADAW), 1024, 0, l * 9216, scr, r, lane);
    }
    const int gt = gw * 64 + lane, NGT = NGW * 64;
    { GAS unsigned* CA = (GAS unsigned*)(ws + WS_CA);
      for (int i = gt; i < 256 * 512; i += NGT) { const int b = i >> 9, k = (i & 511) * 2; float v0 = 0.f, v1 = 0.f;
        if (b < NBATCH) { const float* c = b < 8 ? a->in[I_CP] + (size_t)b * D : a->in[I_CS] + (size_t)(b - 8) * D; v0 = fast_silu(c[k]); v1 = fast_silu(c[k + 1]); }
        CA[i] = cvt_pk_bf16(v0, v1); } }
    { const GAS f32x2* sp = (const GAS f32x2*)a->in[I_SPOOL]; GAS unsigned* hp = (GAS unsigned*)(ws + WS_HISTP);
      for (int i = gt; i < DEPTH * 128 * 15 * 256; i += NGT) { const f32x2 v = sp[i]; hp[i] = cvt_pk_bf16(v.x, v.y); }
      const GAS f32x2* sc = (const GAS f32x2*)a->in[I_SCONV]; GAS unsigned* hc = (GAS unsigned*)(ws + WS_HISTC);
      for (int i = gt; i < DEPTH * 128 * 2 * 256; i += NGT) { const f32x2 v = sc[i]; hc[i] = cvt_pk_bf16(v.x, v.y); } }
    for (int i = gt; i < DEPTH * 8 * 128 * 64; i += NGT) { const int s = (i & 63) * 2, t = (i >> 6) & 127, lh = i >> 13, l = lh >> 3;
        const float* W = a->in[I_WS] + (size_t)lh * 128 * 128; bf16_t* LW = (bf16_t*)(ws + WS_W + (size_t)l * LW_SIZE);
        const float w0 = W[t * 128 + s], w1 = W[t * 128 + s + 1];
        ((GAS unsigned*)(LW + LW_TRIL / 2))[(size_t)(lh & 7) * 8192 + t * 64 + (s >> 1)] = cvt_pk_bf16(s <= t ? w0 : 0.f, s + 1 <= t ? w1 : 0.f);
        const int t8 = t & 7, s8 = s & 7; const bool same = (t >> 3) == (s >> 3);
        const float z0 = (same && s8 <= t8) ? W[t8 * 128 + s8] : 0.f, z1 = (same && s8 + 1 <= t8) ? W[t8 * 128 + s8 + 1] : 0.f;
        ((GAS unsigned*)(LW + LW_SAMP / 2))[(size_t)(lh & 7) * 8192 + t * 64 + (s >> 1)] = cvt_pk_bf16(z0, z1); }
}

__device__ __forceinline__ void phase_prep0(ArgsP a, int gw, int NGW, int lane) {
    const float* MOD = (const float*)(a->ws + WS_MOD); bf16_t* H = (bf16_t*)(a->ws + WS_H); ssq_t* SSQ = (ssq_t*)(a->ws + WS_SSQ);
    for (int row = gw; row < T; row += NGW) {
        const GAS f32x4* xr = (const GAS f32x4*)(row < TP ? a->in[I_XP] + (size_t)row * D : a->in[I_XS] + (size_t)(row - TP) * D) + lane;
        const float* mrow = MOD + (size_t)row_batch(row) * 36864 + D;
        GAS u32x2* o = (GAS u32x2*)(H + (size_t)row * D) + lane;
        float s = 0.f;
#pragma unroll
        for (int j = 0; j < 4; ++j) { const f32x4 v = xr[64 * j]; s += (v.x * v.x + v.y * v.y) + (v.z * v.z + v.w * v.w);
            const f32x4 h = v * *(const GAS f32x4*)(mrow + 4 * lane + 256 * j); u32x2 w; w.x = cvt_pk_bf16(h.x, h.y); w.y = cvt_pk_bf16(h.z, h.w); o[64 * j] = w; }
        s = wave_sum(s, lane);
        if (lane == 0) SSQ[row] = (ssq_t)(s * SSQ_SCALE + 0.5f);
    }
}
__device__ __forceinline__ void phase_final(ArgsP a, int gw, int NGW, int lane) {
    const bf16_t* X = (const bf16_t*)(a->ws + WS_H); const float* g = a->in[I_FNG]; const ssq_t* SSQ = (const ssq_t*)(a->ws + WS_SSQ) + (size_t)12 * T;
    f32x4 gv[4];
#pragma unroll
    for (int j = 0; j < 4; ++j) gv[j] = *(const GAS f32x4*)(g + 4 * lane + 256 * j);
    for (int row = gw; row < T; row += NGW) {
        const GAS u32x2* xr = (const GAS u32x2*)(X + (size_t)row * D) + lane;
        const float rstd = row_rstd(SSQ, row);
        GAS f32x4* o = (GAS f32x4*)(a->out + (size_t)row * D) + lane;
#pragma unroll
        for (int j = 0; j < 4; ++j) { const u32x2 w = xr[64 * j]; const f32x4 xv = (f32x4){bf_lo(w.x), bf_hi(w.x), bf_lo(w.y), bf_hi(w.y)}; o[64 * j] = (xv * rstd) * gv[j]; }
    }
}

__device__ __forceinline__ void gmlp_unit(ArgsP a, LAS unsigned char* lds, int l, int c, int wave, int lane) {
    const bf16_t* P = (const bf16_t*)(a->ws + WS_PA); bf16_t* Y = (bf16_t*)(a->ws + WS_YAB); float* out = a->out;
    const bf16_t* LW = (const bf16_t*)(a->ws + WS_W + (size_t)l * LW_SIZE);
    const int r0 = 128 * c; const bool samp = c >= 128;
    LAS bf16_t* vT = (LAS bf16_t*)lds;
    bf16x8 wfr[20];
    { const int fr = lane & 15, fq = lane >> 4; const bf16_t* Wh = LW + (samp ? LW_SAMP : LW_TRIL) / 2 + (size_t)wave * 128 * 128 + fr * 128 + 8 * fq;
      int wi = 0;
#pragma unroll
      for (int ks = 0; ks < 4; ++ks)
#pragma unroll
          for (int mt = 0; mt < 8; ++mt) if (mt >= 2 * ks) { wfr[wi] = *(const GAS bf16x8*)(Wh + (16 * mt) * 128 + 32 * ks); ++wi; } }
    { float lng[8];
      { const f32x4 g0 = *(const GAS f32x4*)(a->in[I_LNG] + l * 512 + 8 * lane), g1 = *(const GAS f32x4*)(a->in[I_LNG] + l * 512 + 8 * lane + 4);
        lng[0] = g0[0]; lng[1] = g0[1]; lng[2] = g0[2]; lng[3] = g0[3]; lng[4] = g1[0]; lng[5] = g1[1]; lng[6] = g1[2]; lng[7] = g1[3]; }
      const bf16_t* Pw = P + (size_t)(r0 + wave * 16) * 3072; const unsigned l8 = 8u * (unsigned)lane;
      u32x4 raw[16];
#pragma unroll
      for (int i = 0; i < 16; ++i) raw[i] = *(const GAS u32x4*)(Pw + i * 3072 + 2048 + l8);
#pragma unroll
      for (int i = 0; i < 16; ++i) { const int rl = wave * 16 + i, row = r0 + rl; float v[8];
        unpack8(raw[i], v);
        float s = 0.f;
#pragma unroll
        for (int j = 0; j < 8; ++j) s += v[j];
        const float mean = wave_sum(s, lane) * (1.f / 512.f); float q = 0.f;
#pragma unroll
        for (int j = 0; j < 8; ++j) { v[j] -= mean; q += v[j] * v[j]; }
        const float rstd = __builtin_amdgcn_rsqf(wave_sum(q, lane) * (1.f / 512.f) + EPS);
#pragma unroll
        for (int j = 0; j < 8; ++j) v[j] = v[j] * rstd * lng[j];
        if (samp) { float* o = out + O_V + (size_t)l * (128 * 8 * 512) + (size_t)(row - TP) * 512;
            *(GAS f32x4*)(o + l8) = (f32x4){v[0], v[1], v[2], v[3]}; *(GAS f32x4*)(o + 4 + l8) = (f32x4){v[4], v[5], v[6], v[7]}; }
        const u32x4 pk = pack8(v);
        LAS bf16_t* d = vT + (8 * lane) * VT_PITCH + ((((rl >> 3) ^ lane) & 15) << 3) + (rl & 7);
        d[0 * VT_PITCH] = (bf16_t)(pk.x & 0xffff); d[1 * VT_PITCH] = (bf16_t)(pk.x >> 16); d[2 * VT_PITCH] = (bf16_t)(pk.y & 0xffff); d[3 * VT_PITCH] = (bf16_t)(pk.y >> 16);
        d[4 * VT_PITCH] = (bf16_t)(pk.z & 0xffff); d[5 * VT_PITCH] = (bf16_t)(pk.z >> 16); d[6 * VT_PITCH] = (bf16_t)(pk.w & 0xffff); d[7 * VT_PITCH] = (bf16_t)(pk.w >> 16); }
    }
    __syncthreads();
    { const int h = wave, fr = lane & 15, fq = lane >> 4;
      f32x4 acc[8][4];
#pragma unroll
      for (int mt = 0; mt < 8; ++mt)
#pragma unroll
          for (int nt = 0; nt < 4; ++nt) acc[mt][nt] = (f32x4){0.f, 0.f, 0.f, 0.f};
      int wi = 0;
#pragma unroll
      for (int ks = 0; ks < 4; ++ks) { bf16x8 vf[4];
#pragma unroll
          for (int nt = 0; nt < 4; ++nt) { const int dd = h * 64 + 16 * nt + fr; vf[nt] = *(const LAS bf16x8*)(vT + dd * VT_PITCH + ((((4 * ks + fq) ^ (dd >> 3)) & 15) << 3)); }
#pragma unroll
          for (int mt = 0; mt < 8; ++mt) if (mt >= 2 * ks) { const bf16x8 wf = wfr[wi]; ++wi;
#pragma unroll
              for (int nt = 0; nt < 4; ++nt) acc[mt][nt] = __builtin_amdgcn_mfma_f32_16x16x32_bf16(vf[nt], wf, acc[mt][nt], 0, 0, 0); } }
      const float* bs = a->in[I_BS] + (size_t)(l * 8 + h) * 128;
#pragma unroll
      for (int mt = 0; mt < 8; ++mt) { const int t = 16 * mt + fr, row = r0 + t; const float bias = bs[samp ? (t & 7) : t];
          u32x2 ur[4];
#pragma unroll
          for (int nt = 0; nt < 4; ++nt) ur[nt] = *(const GAS u32x2*)(P + (size_t)row * 3072 + 1536 + h * 64 + 16 * nt + 4 * fq);
#pragma unroll
          for (int nt = 0; nt < 4; ++nt) { const int d = h * 64 + 16 * nt + 4 * fq;
              u32x2 w; w.x = cvt_pk_bf16((acc[mt][nt][0] + bias) * bf_lo(ur[nt].x), (acc[mt][nt][1] + bias) * bf_hi(ur[nt].x));
              w.y = cvt_pk_bf16((acc[mt][nt][2] + bias) * bf_lo(ur[nt].y), (acc[mt][nt][3] + bias) * bf_hi(ur[nt].y));
              *(GAS u32x2*)(Y + (size_t)row * D + 512 + d) = w; } }
    }
    __syncthreads();
}
__device__ __forceinline__ void convpool_unit(ArgsP a, int l, int cu, int wave, int lane) {
    const bf16_t* P = (const bf16_t*)(a->ws + WS_PA); bf16_t* Y = (bf16_t*)(a->ws + WS_YAB); bf16_t* YC = (bf16_t*)(a->ws + WS_YC); float* out = a->out;
    const int r0 = 32 * cu + 4 * wave; const bool samp = r0 >= TP;
    const int tpos0 = samp ? ((r0 - TP) & 7) : (r0 & 2047), sq = samp ? ((r0 - TP) >> 3) : (r0 >> 11), L = samp ? 8 : 2048; const unsigned d = 8u * (unsigned)lane;
    const bf16_t* Pr = P + (size_t)r0 * 3072;
    bf16_t* Yr = Y + (size_t)r0 * D; bf16_t* YCr = YC + (size_t)r0 * 512;
    { u32x4 xa[6], cg[6], bg[4];
      const bf16_t* hc = (const bf16_t*)(a->ws + WS_HISTC) + (size_t)(l * 128 + sq) * 2 * 512;
#pragma unroll
      for (int k = 0; k < 6; ++k) { const int tp = tpos0 - 2 + k;
          if (tp >= 0) { xa[k] = *(const GAS u32x4*)(Pr + (k - 2) * 3072 + d); cg[k] = *(const GAS u32x4*)(Pr + (k - 2) * 3072 + 1024 + d); }
          else if (samp) { xa[k] = *(const GAS u32x4*)(hc + (2 + tp) * 512 + d); cg[k] = (u32x4){0x3f803f80u, 0x3f803f80u, 0x3f803f80u, 0x3f803f80u}; }
          else { xa[k] = (u32x4){0u, 0u, 0u, 0u}; cg[k] = xa[k]; } }
#pragma unroll
      for (int j = 0; j < 4; ++j) bg[j] = *(const GAS u32x4*)(Pr + j * 3072 + 512 + d);
      float cw[3][8];
#pragma unroll
      for (int k = 0; k < 3; ++k) { const float* cwp = a->in[I_CONVW] + (size_t)(l * 3 + k) * 512; const f32x4 c0 = *(const GAS f32x4*)(cwp + d), c1 = *(const GAS f32x4*)(cwp + 4 + d);
          cw[k][0] = c0[0]; cw[k][1] = c0[1]; cw[k][2] = c0[2]; cw[k][3] = c0[3]; cw[k][4] = c1[0]; cw[k][5] = c1[1]; cw[k][6] = c1[2]; cw[k][7] = c1[3]; }
      float ci[6][8];
#pragma unroll
      for (int k = 0; k < 6; ++k) { float x8[8], c8[8]; unpack8(xa[k], x8); unpack8(cg[k], c8);
#pragma unroll
          for (int q = 0; q < 8; ++q) ci[k][q] = c8[q] * x8[q]; }
#pragma unroll
      for (int j = 0; j < 4; ++j) { float b8[8], ya[8]; unpack8(bg[j], b8);
#pragma unroll
          for (int q = 0; q < 8; ++q) ya[q] = b8[q] * (cw[0][q] * ci[j][q] + cw[1][q] * ci[j + 1][q] + cw[2][q] * ci[j + 2][q]);
          *(GAS u32x4*)(Yr + j * D + d) = pack8(ya); }
      if (tpos0 == L - 4) {
#pragma unroll
          for (int j = 2; j < 4; ++j) { float* o = out + (samp ? O_CS : O_CP) + ((size_t)(l * (samp ? 128 : 8) + sq) * 2 + (j - 2)) * 512;
              *(GAS f32x4*)(o + d) = (f32x4){ci[j + 2][0], ci[j + 2][1], ci[j + 2][2], ci[j + 2][3]}; *(GAS f32x4*)(o + 4 + d) = (f32x4){ci[j + 2][4], ci[j + 2][5], ci[j + 2][6], ci[j + 2][7]}; } }
    }
    { const int w = 2 << (lane >> 4);
      const bf16_t* hp = (const bf16_t*)(a->ws + WS_HISTP) + (size_t)(l * 128 + sq) * 15 * 512;
      u32x4 raw[19];
#pragma unroll
      for (int i = 0; i < 19; ++i) { const int tp = tpos0 + 3 - i; raw[i] = (u32x4){0u, 0u, 0u, 0u};
          if (i < 5 || i < w + 3) {
              if (tp >= 0) raw[i] = *(const GAS u32x4*)(Pr + (3 - i) * 3072 + 2560 + d);
              else if (samp) raw[i] = *(const GAS u32x4*)(hp + (15 + tp) * 512 + d); } }
      float o[4][8], pc[4][8];
#pragma unroll
      for (int j = 0; j < 4; ++j)
#pragma unroll
          for (int q = 0; q < 8; ++q) { o[j][q] = 0.f; pc[j][q] = 0.f; }
#pragma unroll
      for (int i = 0; i < 19; ++i) { float p8[8]; unpack8(raw[i], p8);
#pragma unroll
          for (int j = 0; j < 4; ++j) { const int ii = i - 3 + j;
              if (ii >= 0 && ii < 16) { const float m = ii < w ? 1.f : 0.f;
#pragma unroll
                  for (int q = 0; q < 8; ++q) o[j][q] += m * p8[q]; }
              if (ii == 0) {
#pragma unroll
                  for (int q = 0; q < 8; ++q) pc[j][q] = p8[q]; } } }
#pragma unroll
      for (int j = 0; j < 4; ++j) { const int tpos = tpos0 + j; const float inv = 1.0f / (float)(samp ? w : (tpos + 1 < w ? tpos + 1 : w)); float yc[8];
#pragma unroll
          for (int q = 0; q < 8; ++q) yc[q] = o[j][q] * inv - pc[j][q];
          *(GAS u32x4*)(YCr + j * 512 + d) = pack8(yc);
          if (samp) { float* oo = out + O_PS + ((size_t)(l * 128 + sq) * 15 + 7 + tpos) * 512;
              *(GAS f32x4*)(oo + d) = (f32x4){pc[j][0], pc[j][1], pc[j][2], pc[j][3]}; *(GAS f32x4*)(oo + 4 + d) = (f32x4){pc[j][4], pc[j][5], pc[j][6], pc[j][7]}; }
          else if (tpos >= 2048 - 15) { float* oo = out + O_PP + ((size_t)(l * 8 + sq) * 15 + (tpos - (2048 - 15))) * 512;
              *(GAS f32x4*)(oo + d) = (f32x4){pc[j][0], pc[j][1], pc[j][2], pc[j][3]}; *(GAS f32x4*)(oo + 4 + d) = (f32x4){pc[j][4], pc[j][5], pc[j][6], pc[j][7]}; } }
      if (samp && tpos0 == 0) {
#pragma unroll
          for (int i = 0; i < 7; ++i) { const float* sp = a->in[I_SPOOL] + ((size_t)(l * 128 + sq) * 15 + 8 + i) * 512; float* o2 = out + O_PS + ((size_t)(l * 128 + sq) * 15 + i) * 512;
              *(GAS f32x4*)(o2 + d) = *(const GAS f32x4*)(sp + d); *(GAS f32x4*)(o2 + 4 + d) = *(const GAS f32x4*)(sp + 4 + d); } }
    }
}

__global__ void __launch_bounds__(512, 2) fwd(Args a_) {
    extern __shared__ __attribute__((aligned(16))) unsigned char lds_raw[];
    LAS unsigned char* lds = (LAS unsigned char*)lds_raw;
    const int G = gridDim.x, bx = blockIdx.x;
#if ONE_LAUNCH
    volatile LAS unsigned* MISC = (volatile LAS unsigned*)(lds + MISC_OFF);
    if (threadIdx.x < 64) MISC[threadIdx.x] = 0u;
    __syncthreads();
    (void)xcd_barrier_post((unsigned*)(a_.ws + WS_CTL) + 4096, MISC + 8);
#endif
    const int ph_lo = a_.ph_lo, ph_hi = a_.ph_hi;
    const int wave0 = __builtin_amdgcn_readfirstlane(threadIdx.x >> 6);
#if ONE_LAUNCH
    if (ph_lo > ph_hi) cg::this_grid().sync();
#endif
    int redo = 0;
    for (int ph = ph_lo; ph < ph_hi; ++ph) {
        ArgsP a = (ArgsP)__builtin_amdgcn_kernarg_segment_ptr(); asm volatile("" : "+s"(a));
        int wave = wave0; asm volatile("" : "+s"(wave));
#define TID() (wave * 64 + opaque_lane())
        unsigned char* ws = a->ws; asm volatile("" : "+s"(ws));
        const int gw = bx * 8 + wave, NGW = G * 8;
        float* MOD = (float*)(ws + WS_MOD); ssq_t* SSQ = (ssq_t*)(ws + WS_SSQ); float* SB = (float*)(ws + WS_SB);
        constexpr size_t TSTEP1K = (size_t)256 * 1024 * 2;
        if (ph == 0) phase_prologue(a, lds, gw, NGW, wave, opaque_lane());
        else if (ph == 1) {
            pg8::Gemm g{(const bf16_t*)(ws + WS_CA), (const bf16_t*)(ws + WS_ADAW), 1024, 1024, 1024, 0, 0, 0}; pg8::StaticOrder S; S.init(1, 36864 / 256, G, bx);
            EpiAda E{MOD, a->in[I_BADA], a->in[I_NORMG], (bf16_t*)(ws + WS_SH)};
            pg8::gemm_phase<EpiAda, pg8::StaticOrder>(lds, g, S, E, TID());
        } else if (ph == 2) {
            for (int sidx = 0; sidx < 3; ++sidx) { const int tid2 = TID();
                pg8::Gemm g{(const bf16_t*)(ws + WS_SH) + (size_t)sidx * 256 * 1024, (const bf16_t*)(ws + WS_W + (sidx == 0 ? LW_GU1 : (sidx == 1 ? LW_IN : LW_GU2))), 1024, 1024, 1024, 0, 3 * TSTEP1K, LW_SIZE};
                pg8::StaticOrder S; S.init(0, 4, sidx == 1 ? 24 : 22, G, bx, sidx == 0 ? 0 : (sidx == 1 ? 88 : 184), sidx == 0 ? 88 : (sidx == 1 ? 96 : 72), 0, 0);
                EpiSB E{SB, sidx == 0 ? 0 : (sidx == 1 ? 5632 : 11776)};
                pg8::gemm_phase<EpiSB, pg8::StaticOrder>(lds, g, S, E, tid2);
            }
            phase_prep0(a, gw, NGW, opaque_lane());
        } else if (ph == NPH - 1) phase_final(a, gw, NGW, opaque_lane());
        else {
            const int l = (ph - 3) >> 3, k = (ph - 3) & 7;
            const bf16_t* LW = (const bf16_t*)(ws + WS_W + (size_t)l * LW_SIZE);
            unsigned* DEP = (unsigned*)(ws + WS_CTL) + 8192 + 64 * 2 * (l * 8 + k);
            bf16_t* GSv = (bf16_t*)(ws + WS_GS) - (size_t)TP * DFF; bf16_t* MGSv = (bf16_t*)(ws + WS_MGS) - (size_t)TP * D;
            if (k == 3) {
                if (bx < T / 128) gmlp_unit(a, lds, l, bx, wave, opaque_lane());
                else for (int u = bx - T / 128; u < T / 32; u += G - T / 128) convpool_unit(a, l, u, wave, opaque_lane());
            } else {
                const bool lastl = (l == DEPTH - 1);
                const int nsteps = (k == 0) ? 2 : (k == 2) ? 5 : (k == 6) ? (lastl ? 6 : 4) : 1;
                for (int st = 0; st < nsteps; ++st) {
                    int ek = 0, samp = 0, jl = l, jsub = 0, nN = 4, cu_off = 0, cu_cnt = G, skc = 0, skr = 0, sig = -1, wt = -1, gu2 = 0, ri0 = 0, rend = 1 << 20, lofs = 0; unsigned wneed = 16u;
                    if (k == 0) { if (st == 0) { if (l > 0) { ek = 2; samp = 1; jl = l - 1; jsub = 2; cu_cnt = 16; sig = 0; } }
                                  else { ek = 1; nN = 22; if (l > 0) { skc = 16; skr = 3; } } }
                    else if (k == 1) { ek = 2; jsub = 0; }
                    else if (k == 2) { if (st == 0) { ek = 1; samp = 1; nN = 22; cu_off = 16; cu_cnt = 88; sig = 0; }
                                       else if (st == 1) { ek = 2; samp = 1; jsub = 0; cu_cnt = 16; wt = 0; wneed = 88u; sig = 1; }
                                       else if (st == 2) { ek = 3; nN = 24; cu_off = 104; cu_cnt = 152; rend = 1; }
                                       else if (st == 3) { ek = 3; nN = 24; skc = 16; skr = 3; lofs = 152; }
                                       else { ek = 3; samp = 1; nN = 24; cu_off = 160; cu_cnt = 96; wt = 1; } }
                    else if (k == 4) { ek = 4; }
                    else if (k == 5) { ek = 2; jsub = 1; }
                    else if (k == 6 && !lastl) { if (st == 0) { ek = 4; samp = 1; cu_cnt = 16; sig = 0; }
                                       else if (st == 1) { ek = 2; samp = 1; jsub = 1; cu_cnt = 16; wt = 0; sig = 1; }
                                       else if (st == 2) { ek = 1; gu2 = 1; nN = 22; skc = 16; skr = 4; }
                                       else { ek = 1; gu2 = 1; samp = 1; nN = 22; cu_off = 168; cu_cnt = 88; wt = 1; } }
                    else if (k == 6) {
                                       if (st == 0) { ek = 4; samp = 1; cu_cnt = 16; sig = 0; }
                                       else if (st == 1) { ek = 2; samp = 1; jsub = 1; cu_cnt = 16; wt = 0; sig = 1; }
                                       else if (st == 2) { ek = 1; gu2 = 1; nN = 22; skc = 16; skr = 5; rend = 3; }
                                       else if (st == 3) { ek = 1; gu2 = 1; samp = 1; nN = 22; cu_off = 168; cu_cnt = 88; wt = 1; sig = 2; }
                                       else if (st == 4) { ek = 1; gu2 = 1; nN = 22; skc = 16; skr = 5; ri0 = 3; }
                                       else { ek = 2; samp = 1; jsub = 2; cu_cnt = 16; wt = 2; wneed = 88u; } }
                    else { ek = 2; jsub = 2; }
                    if (ek == 0) continue;
                    pg8::StaticOrder S; S.init(samp ? 64 : 0, samp ? 4 : 64, nN, G, bx, cu_off, cu_cnt, skc, skr, ri0, rend, lofs);
                    pg8::Unit u0; const bool mine = S.next(0, u0);
                    const bool leader = (TID() == 0);
                    if (wt >= 0 && mine) dep_wait(DEP + 64 * wt, wneed, leader);
                    const bf16_t* JW = (const bf16_t*)(ws + WS_W + (size_t)jl * LW_SIZE);
                    if (ek == 1) {
                        pg8::Gemm g{(const bf16_t*)(ws + WS_H), LW + (gu2 ? LW_GU2 : LW_GU1) / 2, 1024, 1024, 1024, 0, TSTEP1K, 0};
                        EpiSwiglu E{(bf16_t*)(ws + WS_G), GSv, SSQ + (size_t)(3 * l + (gu2 ? 2 : 0)) * T, SB + l * SB_LAYER + (gu2 ? 11776 : 0)};
                        pg8::gemm_phase<EpiSwiglu, pg8::StaticOrder>(lds, g, S, E, TID());
                    } else if (ek == 2) {
                        pg8::Gemm g; float sc;
                        if (jsub == 1) { g = pg8::Gemm{samp ? (const bf16_t*)MGSv : (const bf16_t*)(ws + WS_MG), JW + LW_WO / 2, 1024, 1024, 1024, 0, TSTEP1K, 0}; sc = 1.0f; }
                        else { g = pg8::Gemm{samp ? (const bf16_t*)GSv : (const bf16_t*)(ws + WS_G), JW + (jsub == 0 ? LW_DN1 : LW_DN2) / 2, DFF, DFF, DFF, 0, (size_t)256 * DFF * 2, 0}; sc = 0.5f; }
                        const int nsub = jsub == 2 ? 0 : jsub + 1, nl = jsub == 2 ? (jl == DEPTH - 1 ? jl : jl + 1) : jl; const int fin = (jsub == 2 && jl == DEPTH - 1) ? 1 : 0;
                        EpiResid E{MOD + jl * NADA + (jsub * 3 + 2) * D, MOD + jl * NADA + (jsub * 3 + 1) * D, MOD + nl * NADA + (nsub * 3 + 1) * D, (bf16_t*)(ws + WS_H), SSQ + (size_t)(3 * jl + jsub + 1) * T, sc, fin};
                        pg8::gemm_phase<EpiResid, pg8::StaticOrder>(lds, g, S, E, TID());
                    } else if (ek == 3) {
                        pg8::Gemm g{(const bf16_t*)(ws + WS_H), LW + LW_IN / 2, 1024, 1024, 1024, 0, TSTEP1K, 0};
                        EpiProj E{(bf16_t*)(ws + WS_PA), (bf16_t*)(ws + WS_PG), SSQ + (size_t)(3 * l + 1) * T, SB + l * SB_LAYER + 5632};
                        pg8::gemm_phase<EpiProj, pg8::StaticOrder>(lds, g, S, E, TID());
                    } else {
                        const pg8::Gemm gj[3] = { pg8::Gemm{(const bf16_t*)(ws + WS_YAB), LW + LW_OA / 2, 1024, 512, 512, 0, TSTEP1K, 0},
                                                  pg8::Gemm{(const bf16_t*)(ws + WS_YAB) + 512, LW + LW_OB / 2, 1024, 512, 512, 0, TSTEP1K, 0},
                                                  pg8::Gemm{(const bf16_t*)(ws + WS_YC), LW + LW_PL / 2, 512, 128, 128, 128, (size_t)256 * 512 * 2, 0} };
                        EpiMix E{(bf16_t*)(ws + WS_MG), MGSv, (const bf16_t*)(ws + WS_PG), a->in[I_POOLS] + (size_t)l * D};
                        pg8::gemm_phase3<EpiMix, pg8::StaticOrder>(lds, gj, S, E, TID());
                    }
                    if (sig >= 0 && mine) dep_signal(DEP + 64 * sig, leader);
                }
            }
        }
#if ONE_LAUNCH
        if (PROBE_PRE && ph < 3 && ((PROBE_PRE >> ph) & 1)) { if (!redo) { redo = 1; --ph; } else redo = 0; }
        if (PROBE_MASK && ph >= 3 && ph < NPH - 1 && ((PROBE_MASK >> ((ph - 3) & 7)) & 1)) { if (!redo) { redo = 1; --ph; } else redo = 0; }
        if (ph + 1 < ph_hi) { XcdBarrier bar; bar.bar = (unsigned*)(ws + WS_CTL) + 4096; bar.x = xb_xcc_id(); bar.st = (volatile LAS unsigned*)(lds + MISC_OFF) + 8; xcd_barrier(bar); }
#endif
    }
}

extern "C" void kernel_launch(void* const* d_in, const int* in_sizes, int n_in, void* d_out, int out_size, void* d_ws, size_t ws_size, hipStream_t stream) {
    static int grid = 0;
    if (grid == 0) {
        if (n_in != 24 || (size_t)out_size != O_END || ws_size < WS_END) { fprintf(stderr, "kernel_launch: unexpected sizes n_in %d out %d ws %zu\n", n_in, out_size, ws_size); grid = -1; return; }
        int dev = 0, cus = 0;
        if (hipGetDevice(&dev) != hipSuccess || hipDeviceGetAttribute(&cus, hipDeviceAttributeMultiprocessorCount, dev) != hipSuccess) { grid = -1; return; }
        if (hipFuncSetAttribute((const void*)fwd, hipFuncAttributeMaxDynamicSharedMemorySize, LDS_BYTES) != hipSuccess) { fprintf(stderr, "kernel_launch: hipFuncSetAttribute failed\n"); grid = -1; return; }
        int per_cu = 0; (void)hipOccupancyMaxActiveBlocksPerMultiprocessor(&per_cu, (const void*)fwd, 512, LDS_BYTES); (void)hipGetLastError();
        grid = cus;
    }
    if (grid < 0) return;
    Args a{};
    for (int i = 0; i < 24; ++i) a.in[i] = (const float*)d_in[i];
    a.out = (float*)d_out; a.ws = (unsigned char*)d_ws;
#if ONE_LAUNCH
    (void)hipMemsetAsync((char*)d_ws + WS_CTL, 0, CTL_BYTES, stream);
    (void)hipMemsetAsync((char*)d_ws + WS_SSQ, 0, SSQ_BYTES, stream);
    a.ph_lo = 0; a.ph_hi = NPH;
    void* args[] = {&a};
    hipError_t e = hipLaunchCooperativeKernel((const void*)fwd, dim3(grid), dim3(512), args, LDS_BYTES, stream);
    if (e != hipSuccess) fprintf(stderr, "cooperative launch failed: %s (grid %d)\n", hipGetErrorString(e), grid);
#else
    for (int ph = 0; ph < NPH; ++ph) { a.ph_lo = ph; a.ph_hi = ph + 1; hipLaunchKernelGGL(fwd, dim3(grid), dim3(512), LDS_BYTES, stream, a); }
#endif
}
```
